# Optimizing an MI355X kernel written in HIP

```python
import functools
import jax
import jax.numpy as jnp
from jax import lax
import numpy as np

D_MODEL = 1024
BATCH = 8
SEQ = 2048
DEPTH = 1
DEC_BATCH = 128
DEC_SEQ = 4
PAST_LEN = 16384
PAGE_SIZE = 128

N_META = 16
MIX_WIDTH = D_MODEL
POOL_WIDTH = MIX_WIDTH // 2
POOL_WINDOWS = (2, 4, 8, 16)
POOL_GROUPS = len(POOL_WINDOWS)
POOL_GC = POOL_WIDTH // POOL_GROUPS
POOL_CTX = max(POOL_WINDOWS) - 1
MLSTM_WIDTH = MIX_WIDTH - POOL_WIDTH
N_HEADS = 4
HEAD_DIM = MLSTM_WIDTH // N_HEADS
CHUNK = 64
D_FF = 4 * D_MODEL
EPS = 1e-6
IN_COLS = POOL_WIDTH + 4 * MLSTM_WIDTH + 2 * N_HEADS

kernel_name = "hymba_pool_mlstm_decoder_step"


def rmsnorm(x, g):
    x32 = x.astype(jnp.float32)
    y = x32 * lax.rsqrt(jnp.mean(x32 * x32, axis=-1, keepdims=True) + EPS) * g.astype(jnp.float32)
    return y.astype(x.dtype)


def mixer_inputs(x, norm_g, w_in, b_gate):
    B, T, _ = x.shape
    p = jnp.einsum('btd,dc->btc', rmsnorm(x, norm_g), w_in)
    splits = [POOL_WIDTH, POOL_WIDTH + MLSTM_WIDTH, POOL_WIDTH + 2 * MLSTM_WIDTH,
              POOL_WIDTH + 3 * MLSTM_WIDTH, POOL_WIDTH + 4 * MLSTM_WIDTH]
    u, q, k, v, o, gates = jnp.split(p, splits, axis=-1)

    def heads(z):
        return z.reshape(B, T, N_HEADS, HEAD_DIM).transpose(0, 2, 1, 3).astype(jnp.float32)

    gates = gates.astype(jnp.float32) + b_gate.astype(jnp.float32)
    ig = gates[..., :N_HEADS].transpose(0, 2, 1)
    lf = jax.nn.log_sigmoid(gates[..., N_HEADS:]).transpose(0, 2, 1)
    return u, heads(q) * (HEAD_DIM ** -0.5), heads(k), heads(v), o, ig, lf


def pool_mix(u_ext, pos, w_pool, pool_scale):
    T = u_ext.shape[1] - POOL_CTX
    u32 = u_ext.astype(jnp.float32)
    cs = jnp.pad(jnp.cumsum(u32, axis=1), ((0, 0), (1, 0), (0, 0)))
    u_tok = u32[:, POOL_CTX:]
    outs = []
    for g, w in enumerate(POOL_WINDOWS):
        sl = slice(g * POOL_GC, (g + 1) * POOL_GC)
        wsum = cs[:, POOL_CTX + 1:, sl] - cs[:, POOL_CTX + 1 - w:POOL_CTX + 1 - w + T, sl]
        cnt = jnp.minimum(pos + 1, w).astype(jnp.float32)[None, :, None]
        outs.append(jnp.einsum('btc,cd->btd', wsum / cnt - u_tok[:, :, sl], w_pool[g].astype(jnp.float32)))
    return jnp.concatenate(outs, axis=-1) * pool_scale.astype(jnp.float32)


def mlstm_chunk(carry, inp):
    C0, n0, m0 = carry
    q, k, v, ig, lf = inp
    T = q.shape[2]
    b = jnp.cumsum(lf, axis=-1)
    g = b + m0[..., None]
    mask = jnp.tril(jnp.ones((T, T), dtype=bool))
    dmat = jnp.where(mask, b[..., :, None] - b[..., None, :] + ig[..., None, :], -jnp.inf)
    m = jnp.maximum(g, jnp.max(dmat, axis=-1))
    inter = jnp.exp(g - m)
    qk = jnp.einsum('bhtk,bhsk->bhts', q, k) * jnp.exp(dmat - m[..., None])
    num = inter[..., None] * jnp.einsum('bhtk,bhkv->bhtv', q, C0) + jnp.einsum('bhts,bhsv->bhtv', qk, v)
    den = inter * jnp.einsum('bhtk,bhk->bht', q, n0) + jnp.sum(qk, axis=-1)
    h = num / jnp.maximum(jnp.abs(den), jnp.exp(-m))[..., None]
    m_last = m[..., -1]
    decay0 = jnp.exp(b[..., -1] + m0 - m_last)
    ws = jnp.exp(b[..., -1:] - b + ig - m_last[..., None])
    C1 = decay0[..., None, None] * C0 + jnp.einsum('bhs,bhsk,bhsv->bhkv', ws, k, v)
    n1 = decay0[..., None] * n0 + jnp.einsum('bhs,bhsk->bhk', ws, k)
    return (C1, n1, m_last), h


def mlstm_prompt(q, k, v, ig, lf):
    B, H, L, K = q.shape
    carry = (jnp.zeros((B, H, K, K), jnp.float32), jnp.zeros((B, H, K), jnp.float32),
             jnp.zeros((B, H), jnp.float32))
    carry, h_meta = mlstm_chunk(carry, (q[:, :, :N_META], k[:, :, :N_META], v[:, :, :N_META],
                                        ig[:, :, :N_META], lf[:, :, :N_META]))
    nc = (L - N_META) // CHUNK

    def to_chunks(z):
        z = z[:, :, N_META:]
        return jnp.moveaxis(z.reshape((B, H, nc, CHUNK) + z.shape[3:]), 2, 0)

    carry, h_rest = lax.scan(mlstm_chunk, carry, (to_chunks(q), to_chunks(k), to_chunks(v),
                                                  to_chunks(ig), to_chunks(lf)))
    h_rest = jnp.moveaxis(h_rest, 0, 2).reshape(B, H, nc * CHUNK, K)
    return jnp.concatenate([h_meta, h_rest], axis=2), carry


def mlstm_sample(q, k, v, ig, lf, c0, n0, m0):
    carry = (c0.astype(jnp.float32), n0.astype(jnp.float32), m0.astype(jnp.float32))
    carry, h = mlstm_chunk(carry, (q, k, v, ig, lf))
    return h, carry


def mixer_output(pool_out, h, o, head_gain, w_out, dtype):
    B, H, T, V = h.shape
    h = h * lax.rsqrt(jnp.mean(h * h, axis=-1, keepdims=True) + EPS) * head_gain.astype(jnp.float32)[None, :, None, :]
    h = h.transpose(0, 2, 1, 3).reshape(B, T, MLSTM_WIDTH) * jax.nn.sigmoid(o.astype(jnp.float32))
    mix = jnp.concatenate([pool_out, h], axis=-1).astype(dtype)
    return jnp.einsum('btc,cd->btd', mix, w_out)


def channel_mixer(x, g, w_up, w_down):
    a = jnp.square(jax.nn.relu(jnp.einsum('btd,df->btf', rmsnorm(x, g), w_up)))
    return jnp.einsum('btf,fd->btd', a, w_down)


def block(x, pool_ctx, pos, run_mlstm, norm1, w_in, b_gate, w_pool, pool_scale, head_gain, w_out,
          norm2, w_up, w_down):
    u, q, k, v, o, ig, lf = mixer_inputs(x, norm1, w_in, b_gate)
    u_ext = jnp.concatenate([pool_ctx.astype(u.dtype), u], axis=1)
    pool_out = pool_mix(u_ext, pos, w_pool, pool_scale)
    h, mstate = run_mlstm(q, k, v, ig, lf)
    x = x + mixer_output(pool_out, h, o, head_gain, w_out, x.dtype)
    x = x + channel_mixer(x, norm2, w_up, w_down)
    return x, u_ext[:, -POOL_CTX:], mstate


def setup_inputs(seed: int = 0) -> dict:
    key = jax.random.key(seed)
    ks = jax.random.split(key, 20)
    f32 = jnp.float32
    nrm = lambda k, s, sc: jax.random.normal(k, s, f32) * sc
    b_forget = jnp.linspace(3.0, 6.0, N_HEADS)[None, :] + nrm(ks[9], (DEPTH, N_HEADS), 0.1)
    b_input = nrm(ks[10], (DEPTH, N_HEADS), 0.1)
    return {
        'x_prompt': nrm(ks[0], (BATCH, SEQ, D_MODEL), 1.0),
        'x_sample': nrm(ks[1], (DEC_BATCH, DEC_SEQ, D_MODEL), 1.0),
        'state_pool': nrm(ks[2], (DEPTH, DEC_BATCH, POOL_CTX, POOL_WIDTH), 1.0),
        'state_C': nrm(ks[3], (DEPTH, DEC_BATCH, N_HEADS, HEAD_DIM, HEAD_DIM), 0.3),
        'state_n': nrm(ks[4], (DEPTH, DEC_BATCH, N_HEADS, HEAD_DIM), 0.3),
        'state_m': nrm(ks[5], (DEPTH, DEC_BATCH, N_HEADS), 0.5),
        'meta_tokens': nrm(ks[6], (N_META, D_MODEL), 1.0),
        'norm1': 1.0 + nrm(ks[7], (DEPTH, D_MODEL), 0.05),
        'w_in': nrm(ks[8], (DEPTH, D_MODEL, IN_COLS), D_MODEL ** -0.5),
        'b_gate': jnp.concatenate([b_input, b_forget], axis=-1),
        'w_pool': nrm(ks[11], (DEPTH, POOL_GROUPS, POOL_GC, POOL_GC), POOL_GC ** -0.5),
        'pool_scale': 1.0 + nrm(ks[12], (DEPTH, POOL_WIDTH), 0.1),
        'head_gain': 1.0 + nrm(ks[13], (DEPTH, N_HEADS, HEAD_DIM), 0.05),
        'w_out': nrm(ks[14], (DEPTH, MIX_WIDTH, D_MODEL), MIX_WIDTH ** -0.5),
        'norm2': 1.0 + nrm(ks[15], (DEPTH, D_MODEL), 0.05),
        'w_up': nrm(ks[16], (DEPTH, D_MODEL, D_FF), D_MODEL ** -0.5),
        'w_down': nrm(ks[17], (DEPTH, D_FF, D_MODEL), D_FF ** -0.5),
        'norm_f': 1.0 + nrm(ks[18], (D_MODEL,), 0.05),
    }


def reference(x_prompt, x_sample, state_pool, state_C, state_n, state_m, meta_tokens, norm1, w_in,
              b_gate, w_pool, pool_scale, head_gain, w_out, norm2, w_up, w_down, norm_f):
    dtype = x_prompt.dtype
    B = x_prompt.shape[0]
    xp = jnp.concatenate([jnp.broadcast_to(meta_tokens.astype(dtype)[None], (B, N_META, D_MODEL)),
                          x_prompt], axis=1)
    xs = x_sample
    pos_p = jnp.arange(xp.shape[1], dtype=jnp.int32)
    pos_s = PAST_LEN + jnp.arange(xs.shape[1], dtype=jnp.int32)
    zero_ctx = jnp.zeros((B, POOL_CTX, POOL_WIDTH), dtype)
    pool_p, c_p, n_p, m_p, pool_s, c_s, n_s, m_s = [], [], [], [], [], [], [], []
    for l in range(DEPTH):
        w = (norm1[l], w_in[l], b_gate[l], w_pool[l], pool_scale[l], head_gain[l], w_out[l],
             norm2[l], w_up[l], w_down[l])
        xp, pp, (cp, np_, mp) = block(xp, zero_ctx, pos_p, mlstm_prompt, *w)
        run_s = functools.partial(mlstm_sample, c0=state_C[l], n0=state_n[l], m0=state_m[l])
        xs, ps, (cs, ns, ms) = block(xs, state_pool[l], pos_s, run_s, *w)
        pool_p.append(pp); c_p.append(cp); n_p.append(np_); m_p.append(mp)
        pool_s.append(ps); c_s.append(cs); n_s.append(ns); m_s.append(ms)
    y_prompt = rmsnorm(xp[:, N_META:], norm_f)
    y_sample = rmsnorm(xs, norm_f)
    return (y_prompt, y_sample, jnp.stack(pool_p), jnp.stack(c_p), jnp.stack(n_p), jnp.stack(m_p),
            jnp.stack(pool_s), jnp.stack(c_s), jnp.stack(n_s), jnp.stack(m_s))
```

```cpp
#include <hip/hip_runtime.h>
#include <cstdio>
#include <cstdint>
namespace pg8 {
#define PG8_LAS __attribute__((address_space(3)))
typedef unsigned short bf16_t;
typedef short bf16x8 __attribute__((ext_vector_type(8)));
typedef float f32x4 __attribute__((ext_vector_type(4)));
typedef unsigned u32x4 __attribute__((ext_vector_type(4)));
constexpr int BM = 256, BK = 64, HALF = 128, HTB = HALF * BK * 2  , STAGE_BYTES = 8 * HTB, NXCD = 8, WGM = 8;

__host__ __device__ __forceinline__ int lds_byte(int r, int c) { const int st = (r >> 4) * 2 + (c >> 5), rr = r & 15, cc = c & 31, ob = rr * 64 + cc * 2; return st * 1024 + (ob ^ (((ob >> 9) & 1) << 5)); }
__host__ __device__ __forceinline__ void stage_rc(int b, int& R, int& C) { const int st = b / 1024, sb = b % 1024, swz = sb ^ (((sb >> 9) & 1) << 5); R = (st >> 1) * 16 + swz / 64; C = (st & 1) * 32 + (swz % 64) / 2; }
__host__ __device__ __forceinline__ int perm32(int rho) { const int n = rho >> 4, i = rho & 15; return 8 * (i >> 2) + 4 * n + (i & 3); }

struct Unit { int pm, pn; };
struct Gemm { const bf16_t* A; const bf16_t* Bt; int M, N, K; };

struct StaticOrder {
    int nM, nN, nwg, G, c;
    __host__ __device__ void init(int M, int N, int G_, int c_) { nM = M / BM; nN = N / BM; nwg = nM * nN; G = G_; c = c_; }
    __host__ __device__ bool next(int i, Unit& u) const {
        const long L = (long)i * G + c; if (L >= nwg) return false;
        int wgid = (int)L; { const int q = nwg / NXCD, r = nwg % NXCD, xcd = wgid % NXCD, off = wgid / NXCD; wgid = (xcd < r ? xcd * (q + 1) : r * (q + 1) + (xcd - r) * q) + off; }
        const int nig = WGM * nN, gid = wgid / nig, fm = gid * WGM, gsz = (nM - fm) < WGM ? (nM - fm) : WGM;
        u.pm = fm + ((wgid % nig) % gsz); u.pn = (wgid % nig) / gsz; return true;
    }
    __device__ __forceinline__ void a_ready(const Unit&) const {}
    __device__ __forceinline__ void done(const Unit&) const {}
};

__device__ __forceinline__ unsigned cvt_pk_bf16(float lo, float hi) { unsigned r; asm volatile("v_cvt_pk_bf16_f32 %0, %1, %2" : "=v"(r) : "v"(lo), "v"(hi)); return r; }

struct EpiIn {
    static constexpr bool PERM = true, AFTER_DRAIN = false;
    bf16_t* O; size_t split_stride; float qscale;
    __device__ __forceinline__ void operator()(const f32x4 (&acc)[2][2][4][2], const Unit& u, int wr, int wc, int fr, int fq) const {
        const int row0 = u.pm * BM + wr * 64 + fr; const int t = u.pn >> 1; const int colt = (u.pn & 1) * BM;
        bf16_t* base = O + (size_t)t * split_stride; const float sc = (t == 1) ? qscale : 1.f;
        const int col0 = colt + wc * 32 + 8 * fq;
#pragma unroll
        for (int ai = 0; ai < 2; ++ai)
#pragma unroll
            for (int m = 0; m < 4; ++m) { bf16_t* rowp = base + (size_t)(row0 + ai * HALF + m * 16) * 512 + col0;
#pragma unroll
                for (int bj = 0; bj < 2; ++bj) { f32x4 v0 = acc[ai][bj][m][0] * sc, v1 = acc[ai][bj][m][1] * sc;
                    u32x4 w; w.x = cvt_pk_bf16(v0[0], v0[1]); w.y = cvt_pk_bf16(v0[2], v0[3]); w.z = cvt_pk_bf16(v1[0], v1[1]); w.w = cvt_pk_bf16(v1[2], v1[3]);
                    *(u32x4*)(rowp + bj * HALF) = w; } }
    }
};
struct EpiRelu2 {
    static constexpr bool PERM = true, AFTER_DRAIN = false;
    bf16_t* O; int ldc;
    __device__ __forceinline__ void operator()(const f32x4 (&acc)[2][2][4][2], const Unit& u, int wr, int wc, int fr, int fq) const {
        const int row0 = u.pm * BM + wr * 64 + fr; const int col0 = u.pn * BM + wc * 32 + 8 * fq;
#pragma unroll
        for (int ai = 0; ai < 2; ++ai)
#pragma unroll
            for (int m = 0; m < 4; ++m) { bf16_t* rowp = O + (size_t)(row0 + ai * HALF + m * 16) * ldc + col0;
#pragma unroll
                for (int bj = 0; bj < 2; ++bj) { f32x4 v0 = acc[ai][bj][m][0], v1 = acc[ai][bj][m][1];
#pragma unroll
                    for (int e = 0; e < 4; ++e) { const float a = fmaxf(v0[e], 0.f), b = fmaxf(v1[e], 0.f); v0[e] = a * a; v1[e] = b * b; }
                    u32x4 w; w.x = cvt_pk_bf16(v0[0], v0[1]); w.y = cvt_pk_bf16(v0[2], v0[3]); w.z = cvt_pk_bf16(v1[0], v1[1]); w.w = cvt_pk_bf16(v1[2], v1[3]);
                    *(u32x4*)(rowp + bj * HALF) = w; } }
    }
};
struct EpiRes {
    static constexpr bool PERM = false, AFTER_DRAIN = false;
    const float* resA; const float* resB; int split_pm; float* out;
    __device__ __forceinline__ void operator()(const f32x4 (&acc)[2][2][4][2], const Unit& u, int wr, int wc, int fr, int fq) const {
        const int row0 = u.pm * BM + wr * 64 + fr, col0 = u.pn * BM + wc * 32 + 4 * fq;
        const float* res = (u.pm < split_pm) ? resA : (resB - (size_t)split_pm * BM * 1024);
#pragma unroll
        for (int ai = 0; ai < 2; ++ai)
#pragma unroll
            for (int m = 0; m < 4; ++m) { const size_t off = (size_t)(row0 + ai * HALF + m * 16) * 1024 + col0;
#pragma unroll
                for (int bj = 0; bj < 2; ++bj)
#pragma unroll
                    for (int n = 0; n < 2; ++n) { const f32x4 r = *(const f32x4*)(res + off + bj * HALF + n * 16); *(f32x4*)(out + off + bj * HALF + n * 16) = r + acc[ai][bj][m][n]; } }
    }
};

template <class Epi, class Sched, bool ALIGN_EPI = false, bool SP2 = false>
__device__ __forceinline__ void gemm_phase(PG8_LAS unsigned char* lds, const Gemm g, const Sched& S, const Epi& E) {
    const int tid = threadIdx.x, wid = __builtin_amdgcn_readfirstlane(tid >> 6), lane = tid & 63, wr = wid >> 2, wc = wid & 3, fr = lane & 15, fq = lane >> 4;
    const int K = g.K, nt = K / BK;
    unsigned voffA[2], voffB[2];
#pragma unroll
    for (int i = 0; i < 2; ++i) { int R, C; stage_rc(tid * 16 + i * 8192, R, C); const int Rb = Epi::PERM ? ((R & ~31) + perm32(R & 31)) : R;
        voffA[i] = (unsigned)(R * K + C) * 2u; voffB[i] = (unsigned)(Rb * K + C) * 2u; }
    const size_t kstep = (size_t)(BK * 2);
    const size_t hstep = (size_t)HALF * K * 2;
    const size_t tstep = 2 * hstep;
    const unsigned ldsw = (unsigned)wid * 1024u;
    const int aoff = lds_byte(wr * 64 + fr, fq * 8), boff = lds_byte(wc * 32 + fr, fq * 8);
#define PG8_SA(b, h) (((b) * 2 + (h)) * HTB)
#define PG8_SB(b, h) ((4 + (b) * 2 + (h)) * HTB)
#define PG8_STAGE(bufoff, gbase, voff) do { _Pragma("unroll") for (int _i = 0; _i < 2; ++_i) \
        __builtin_amdgcn_global_load_lds((const unsigned*)((const char*)(gbase) + (voff)[_i]), (PG8_LAS unsigned*)(lds + (bufoff) + ldsw + _i * 8192), 16, 0, 0); } while (0)
#define PG8_LDA(dst, b, h) do { _Pragma("unroll") for (int m = 0; m < 4; ++m) _Pragma("unroll") for (int k = 0; k < 2; ++k) dst[m][k] = *(const PG8_LAS bf16x8*)(lds + PG8_SA(b, h) + aoff + m * 2048 + k * 1024); } while (0)
#define PG8_LDB(dst, b, h) do { _Pragma("unroll") for (int n = 0; n < 2; ++n) _Pragma("unroll") for (int k = 0; k < 2; ++k) dst[n][k] = *(const PG8_LAS bf16x8*)(lds + PG8_SB(b, h) + boff + n * 2048 + k * 1024); } while (0)
#define PG8_MMA(ai, bj, At, Bt) do { __builtin_amdgcn_s_setprio(1); _Pragma("unroll") for (int m = 0; m < 4; ++m) _Pragma("unroll") for (int n = 0; n < 2; ++n) _Pragma("unroll") for (int k = 0; k < 2; ++k) \
        acc[ai][bj][m][n] = __builtin_amdgcn_mfma_f32_16x16x32_bf16(Bt[n][k], At[m][k], acc[ai][bj][m][n], 0, 0, 0); __builtin_amdgcn_s_setprio(0); } while (0)
#define PG8_WAIT_V(n) asm volatile("s_waitcnt vmcnt(" #n ")" ::: "memory")
#define PG8_WAIT_L(n) asm volatile("s_waitcnt lgkmcnt(" #n ")" ::: "memory")
#define PG8_BAR __builtin_amdgcn_s_barrier()
#define PG8_SCHED __builtin_amdgcn_sched_barrier(0)
    Unit cur, nxt; int ui = 0;
    if (!S.next(0, cur)) return;
    f32x4 acc[2][2][4][2];
#pragma unroll
    for (int a = 0; a < 2; ++a)
#pragma unroll
        for (int b = 0; b < 2; ++b)
#pragma unroll
            for (int m = 0; m < 4; ++m)
#pragma unroll
                for (int n = 0; n < 2; ++n) acc[a][b][m][n] = (f32x4){0.f, 0.f, 0.f, 0.f};
    bf16x8 At[4][2], B0[2][2], B1[2][2];
    const char* cA = (const char*)g.A + (size_t)cur.pm * tstep; const char* cB = (const char*)g.Bt + (size_t)cur.pn * tstep;
    S.a_ready(cur);
    if constexpr (SP2) {
        PG8_STAGE(PG8_SB(0, 0), cB, voffB); PG8_STAGE(PG8_SB(0, 1), cB + hstep, voffB); PG8_STAGE(PG8_SA(0, 0), cA, voffA); PG8_STAGE(PG8_SA(0, 1), cA + hstep, voffA);
        if (wr == 1) PG8_BAR;
        PG8_WAIT_V(2); PG8_BAR;
        PG8_STAGE(PG8_SB(1, 0), cB + kstep, voffB); PG8_STAGE(PG8_SA(1, 0), cA + kstep, voffA); PG8_STAGE(PG8_SB(1, 1), cB + hstep + kstep, voffB);
        PG8_WAIT_V(6); PG8_BAR;
    } else {
        PG8_STAGE(PG8_SB(0, 0), cB, voffB); PG8_STAGE(PG8_SA(0, 0), cA, voffA); PG8_STAGE(PG8_SB(0, 1), cB + hstep, voffB); PG8_STAGE(PG8_SA(0, 1), cA + hstep, voffA);
        if (wr == 1) PG8_BAR;
        PG8_WAIT_V(4); PG8_BAR;
        PG8_STAGE(PG8_SB(1, 0), cB + kstep, voffB); PG8_STAGE(PG8_SA(1, 0), cA + kstep, voffA); PG8_STAGE(PG8_SB(1, 1), cB + hstep + kstep, voffB);
        PG8_WAIT_V(6); PG8_BAR;
    }
    for (;;) {
        const bool has_next = S.next(ui + 1, nxt);
        const char* nA = has_next ? (const char*)g.A + (size_t)nxt.pm * tstep : cA; const char* nB = has_next ? (const char*)g.Bt + (size_t)nxt.pn * tstep : cB;
        for (int t = 0; t < nt; t += 2) {
            const bool last = (t == nt - 2);
            const char* a1 = cA + (size_t)(t + 1) * kstep;
            const char* a2 = last ? nA : cA + (size_t)(t + 2) * kstep; const char* b2 = last ? nB : cB + (size_t)(t + 2) * kstep;
            const char* a3 = a2 + kstep; const char* b3 = b2 + kstep;
            if (last && has_next) S.a_ready(nxt);
            if constexpr (SP2) {
            PG8_LDB(B0, 0, 0); PG8_LDB(B1, 0, 1); PG8_SCHED; PG8_LDA(At, 0, 0); PG8_STAGE(PG8_SA(1, 1), a1 + hstep, voffA);
            PG8_WAIT_V(8); PG8_WAIT_L(0); PG8_BAR; PG8_MMA(0, 0, At, B0); PG8_MMA(0, 1, At, B1); PG8_BAR; PG8_SCHED;
            PG8_LDA(At, 0, 1); PG8_STAGE(PG8_SB(0, 0), b2, voffB); PG8_STAGE(PG8_SB(0, 1), b2 + hstep, voffB); PG8_STAGE(PG8_SA(0, 0), a2, voffA);
            PG8_WAIT_V(8); PG8_WAIT_L(0); PG8_BAR; PG8_MMA(1, 0, At, B0); PG8_MMA(1, 1, At, B1); PG8_BAR; PG8_SCHED;
            PG8_LDB(B0, 1, 0); PG8_LDB(B1, 1, 1); PG8_SCHED; PG8_LDA(At, 1, 0); PG8_STAGE(PG8_SA(0, 1), a2 + hstep, voffA);
            PG8_WAIT_V(8); PG8_WAIT_L(0); PG8_BAR; PG8_MMA(0, 0, At, B0); PG8_MMA(0, 1, At, B1); PG8_BAR; PG8_SCHED;
            PG8_LDA(At, 1, 1); PG8_STAGE(PG8_SB(1, 0), b3, voffB); PG8_STAGE(PG8_SB(1, 1), b3 + hstep, voffB); PG8_STAGE(PG8_SA(1, 0), a3, voffA);
            PG8_WAIT_V(8); PG8_WAIT_L(0); PG8_BAR; PG8_MMA(1, 0, At, B0); PG8_MMA(1, 1, At, B1); PG8_BAR; PG8_SCHED;
            } else {
            PG8_LDB(B0, 0, 0); PG8_SCHED; PG8_LDA(At, 0, 0); PG8_STAGE(PG8_SA(1, 1), a1 + hstep, voffA);
            PG8_WAIT_L(8); PG8_BAR; PG8_WAIT_L(0); PG8_MMA(0, 0, At, B0); PG8_BAR; PG8_SCHED;
            PG8_LDB(B1, 0, 1); PG8_STAGE(PG8_SB(0, 0), b2, voffB);
            PG8_BAR; PG8_WAIT_L(0); PG8_MMA(0, 1, At, B1); PG8_BAR;
            PG8_LDA(At, 0, 1); PG8_STAGE(PG8_SA(0, 0), a2, voffA);
            PG8_BAR; PG8_WAIT_L(0); PG8_MMA(1, 0, At, B0); PG8_BAR; PG8_SCHED;
            PG8_STAGE(PG8_SB(0, 1), b2 + hstep, voffB);
            PG8_WAIT_V(6); PG8_BAR; PG8_MMA(1, 1, At, B1); PG8_BAR;
            PG8_LDB(B0, 1, 0); PG8_SCHED; PG8_LDA(At, 1, 0); PG8_STAGE(PG8_SA(0, 1), a2 + hstep, voffA);
            PG8_WAIT_L(8); PG8_BAR; PG8_WAIT_L(0); PG8_MMA(0, 0, At, B0); PG8_BAR; PG8_SCHED;
            PG8_LDB(B1, 1, 1); PG8_STAGE(PG8_SB(1, 0), b3, voffB);
            PG8_BAR; PG8_WAIT_L(0); PG8_MMA(0, 1, At, B1); PG8_BAR;
            PG8_LDA(At, 1, 1); PG8_STAGE(PG8_SA(1, 0), a3, voffA);
            PG8_BAR; PG8_WAIT_L(0); PG8_MMA(1, 0, At, B0); PG8_BAR; PG8_SCHED;
            PG8_STAGE(PG8_SB(1, 1), b3 + hstep, voffB);
            PG8_WAIT_V(6); PG8_BAR; PG8_MMA(1, 1, At, B1); PG8_BAR;
            }
        }
        if constexpr (ALIGN_EPI) { if (wr == 0) PG8_BAR; }
        if constexpr (!Epi::AFTER_DRAIN) { E(acc, cur, wr, wc, fr, fq); S.done(cur); }
        if (!has_next) break;
#pragma unroll
        for (int a = 0; a < 2; ++a)
#pragma unroll
            for (int b = 0; b < 2; ++b)
#pragma unroll
                for (int m = 0; m < 4; ++m)
#pragma unroll
                    for (int n = 0; n < 2; ++n) acc[a][b][m][n] = (f32x4){0.f, 0.f, 0.f, 0.f};
        cur = nxt; cA = nA; cB = nB; ++ui;
        if constexpr (ALIGN_EPI) { if (wr == 1) PG8_BAR; }
    }
    PG8_WAIT_V(0);
    if constexpr (!ALIGN_EPI) { if (wr == 0) PG8_BAR; }
    PG8_BAR;
    if constexpr (Epi::AFTER_DRAIN) { E.fused(acc, cur, wr, wc, fr, fq, lds, wid, lane); S.done(cur); }
#undef PG8_SA
#undef PG8_SB
#undef PG8_STAGE
#undef PG8_LDA
#undef PG8_LDB
#undef PG8_MMA
#undef PG8_WAIT_V
#undef PG8_WAIT_L
#undef PG8_BAR
#undef PG8_SCHED
}
}
#ifndef PG8_SP2
#define PG8_SP2 true
#endif
#ifndef PG8_ALIGN
#define PG8_ALIGN true
#endif
constexpr int NWAVES = 8;
constexpr int D = 1024, NB = 8, SEQ = 2048, DECB = 128, DECT = 4, NMETA = 16;
constexpr int PW = 512, NH = 4, HD = 128, FF = 4096, INC = 2568, NIN = 2560;
constexpr int R_PROMPT = NB * SEQ;
constexpr int R_SAMPLE = DECB * DECT;
constexpr int R_MAIN = R_PROMPT + R_SAMPLE;
constexpr int R_META0 = R_MAIN;
constexpr int R_IN = R_MAIN + NMETA;
constexpr int M_IN = 17152;
constexpr int LP = SEQ + NMETA;
constexpr float EPS = 1e-6f;
constexpr size_t MiB = 1u << 20;
constexpr size_t WS_CTL = 0, CTL_ZERO_BYTES = 1 * MiB;
constexpr size_t WS_WIN = 1 * MiB, WS_WOUT = 6 * MiB, WS_WUP = 8 * MiB, WS_WDN = 16 * MiB;
constexpr size_t WS_G = 24 * MiB;
constexpr size_t WS_XN = 25 * MiB;
constexpr size_t WS_P = 59 * MiB;
constexpr size_t P_STRIDE = (size_t)M_IN * 512;
constexpr size_t WS_MIX = 143 * MiB;
constexpr size_t WS_HRAW = 176 * MiB;
constexpr size_t WS_H = 59 * MiB;
constexpr size_t WS_END = 209 * MiB;
static_assert(WS_P + 5 * P_STRIDE * 2 <= WS_MIX && WS_MIX + (size_t)R_MAIN * 1024 * 2 <= WS_HRAW && WS_HRAW + (size_t)R_MAIN * 512 * 4 <= WS_END && WS_H + (size_t)R_MAIN * FF * 2 <= WS_END, "d_ws map");
constexpr size_t O_Y = 0, O_POOLP = 17301504, O_CP = 17362944, O_NP = 17887232, O_MP = 17891328, O_POOLS = 17891360, O_CS = 18874400, O_NS = 27263008, O_MS = 27328544, O_END = 27329056;
constexpr int RING_BYTES = 131072, LDS_BYTES = 147456, MISC_OFF = RING_BYTES + 320;

#define GAS __attribute__((address_space(1)))
#define LAS __attribute__((address_space(3)))
typedef unsigned short bf16;
typedef unsigned v4u __attribute__((ext_vector_type(4)));
typedef unsigned v2u __attribute__((ext_vector_type(2)));
typedef float f32x4 __attribute__((ext_vector_type(4)));
typedef float f32x2 __attribute__((ext_vector_type(2)));
#define LDS_WAIT() asm volatile("s_waitcnt lgkmcnt(0)" ::: "memory")
#define VM_WAIT() asm volatile("s_waitcnt vmcnt(0)" ::: "memory")
__device__ __forceinline__ unsigned f2bf(float f) { unsigned u = __builtin_bit_cast(unsigned, f); return (u + 0x7fffu + ((u >> 16) & 1u)) >> 16; }
__device__ __forceinline__ unsigned pk2(float lo, float hi) { return f2bf(lo) | (f2bf(hi) << 16); }
__device__ __forceinline__ float bf2f(unsigned short b) { return __builtin_bit_cast(float, (unsigned)b << 16); }
__device__ __forceinline__ float bflo(unsigned w) { return __builtin_bit_cast(float, w << 16); }
__device__ __forceinline__ float bfhi(unsigned w) { return __builtin_bit_cast(float, w & 0xffff0000u); }
__device__ __forceinline__ float wave_sum(float v) {
#pragma unroll
    for (int o = 1; o < 64; o <<= 1) v += __shfl_xor(v, o);
    return v;
}
__device__ __forceinline__ float sigmoidf_(float x) { return 1.f / (1.f + __expf(-x)); }
__device__ __forceinline__ float logsigmoidf_(float x) { return fminf(x, 0.f) - log1pf(expf(-fabsf(x))); }

struct Frame {
    LAS unsigned char* lds;
    int tid, lane, wave, G, gw, NGW;
    const float *x_prompt, *x_sample, *state_pool, *state_C, *state_n, *state_m, *meta, *norm1, *w_in, *b_gate, *w_pool, *pool_scale, *head_gain, *w_out, *norm2, *w_up, *w_down, *norm_f;
    float* out;
    bf16 *Win_t, *Wout_t, *Wup_t, *Wdn_t, *XN, *P, *MIX, *H;
    float *Gt, *HRAW;
};

__device__ __forceinline__ void p0_transpose_item(const float* W, int K, int ldw, int ncols, bf16* WT, LAS float* scr, int item, int lane) {
    const int nblk = ncols / 32, kb = item / nblk, nb = item % nblk, k0 = 64 * kb, n0 = 32 * nb;
#pragma unroll 8
    for (int i = 0; i < 32; ++i) { const int kk = 2 * i + (lane >> 5); scr[kk * 33 + (lane & 31)] = W[(size_t)(k0 + kk) * ldw + n0 + (lane & 31)]; }
    LDS_WAIT(); asm volatile("" ::: "memory");
    const int c = lane & 7;
#pragma unroll
    for (int j = 0; j < 4; ++j) { const int n = (lane >> 3) + 8 * j; const LAS float* s = scr + (8 * c) * 33 + n;
        v4u o; o.x = pk2(s[0 * 33], s[1 * 33]); o.y = pk2(s[2 * 33], s[3 * 33]); o.z = pk2(s[4 * 33], s[5 * 33]); o.w = pk2(s[6 * 33], s[7 * 33]);
        *(GAS v4u*)(WT + (size_t)(n0 + n) * K + k0 + 8 * c) = o; }
    LDS_WAIT(); asm volatile("" ::: "memory");
}
__device__ __forceinline__ const float* in_row_ptr(const Frame& F, int r) {
    return r < R_PROMPT ? F.x_prompt + (size_t)r * D : (r < R_MAIN ? F.x_sample + (size_t)(r - R_PROMPT) * D : F.meta + (size_t)(r - R_META0) * D);
}
__device__ __forceinline__ void rms_row_to_bf16(const float* xrow, const float* g, bf16* orow, int lane, f32x4 (&xn)[4]) {
    const GAS f32x4* xr = (const GAS f32x4*)xrow + lane; const GAS f32x4* gr = (const GAS f32x4*)g + lane;
    float s = 0.f;
#pragma unroll
    for (int j = 0; j < 4; ++j) { xn[j] = xr[64 * j]; s += (xn[j].x * xn[j].x + xn[j].y * xn[j].y) + (xn[j].z * xn[j].z + xn[j].w * xn[j].w); }
    const float r = 1.f / sqrtf(wave_sum(s) * (1.f / D) + EPS);
    GAS v2u* o8 = (GAS v2u*)orow + lane;
#pragma unroll
    for (int j = 0; j < 4; ++j) { xn[j] = xn[j] * r * gr[64 * j]; v2u w; w.x = pk2(xn[j].x, xn[j].y); w.y = pk2(xn[j].z, xn[j].w); o8[64 * j] = w; }
}
__device__ __forceinline__ void p0_prologue(Frame& F) {
    LAS float* scr = (LAS float*)(F.lds + F.wave * 8448);
    LAS float* wgL = (LAS float*)(F.lds + 69632);
    for (int e = F.tid; e < 8 * D; e += NWAVES * 64) { const int g = e >> 10, k = e & 1023; wgL[e] = F.w_in[(size_t)k * INC + NIN + g]; }
    constexpr int I_IN = (D / 64) * (NIN / 32), I_OUT = (D / 64) * (D / 32), I_UP = (D / 64) * (FF / 32), I_DN = (FF / 64) * (D / 32);
    constexpr int NITEMS = I_IN + I_OUT + I_UP + I_DN;
    for (int it = F.gw; it < NITEMS; it += F.NGW) {
        int r = it;
        if (r < I_IN) { p0_transpose_item(F.w_in, D, INC, NIN, F.Win_t, scr, r, F.lane); continue; } r -= I_IN;
        if (r < I_OUT) { p0_transpose_item(F.w_out, D, D, D, F.Wout_t, scr, r, F.lane); continue; } r -= I_OUT;
        if (r < I_UP) { p0_transpose_item(F.w_up, D, FF, FF, F.Wup_t, scr, r, F.lane); continue; } r -= I_UP;
        p0_transpose_item(F.w_down, FF, D, D, F.Wdn_t, scr, r, F.lane);
    }
    __syncthreads();
    for (int m = F.gw; m < M_IN; m += F.NGW) {
        bf16* orow = F.XN + (size_t)m * D;
        if (m >= R_IN) { GAS v2u* o8 = (GAS v2u*)orow + F.lane; v2u z; z.x = 0u; z.y = 0u;
#pragma unroll
            for (int j = 0; j < 4; ++j) o8[64 * j] = z;
            if (F.lane < 8) F.Gt[(size_t)m * 8 + F.lane] = 0.f;
            continue; }
        f32x4 xn[4];
        rms_row_to_bf16(in_row_ptr(F, m), F.norm1, orow, F.lane, xn);
        float gs[8];
#pragma unroll
        for (int g = 0; g < 8; ++g) { float s = 0.f;
#pragma unroll
            for (int j = 0; j < 4; ++j) { const f32x4 w = *(const LAS f32x4*)(wgL + g * D + 4 * F.lane + 256 * j); s += (xn[j].x * w.x + xn[j].y * w.y) + (xn[j].z * w.z + xn[j].w * w.w); }
            gs[g] = wave_sum(s); }
        float val = gs[0];
#pragma unroll
        for (int g = 1; g < 8; ++g) val = (F.lane == g) ? gs[g] : val;
        if (F.lane < 8) { val += F.b_gate[F.lane]; F.Gt[(size_t)m * 8 + F.lane] = (F.lane < 4) ? val : logsigmoidf_(val); }
    }
}

struct RecState { float C[2][4]; float n[2]; float m; };
__device__ __forceinline__ void rec_step(const Frame& F, RecState& S, int row, int h, int v0, int lane, bool write_h) {
    const bf16* q = F.P + 1 * P_STRIDE + (size_t)row * 512 + h * HD; const bf16* k = F.P + 2 * P_STRIDE + (size_t)row * 512 + h * HD; const bf16* v = F.P + 3 * P_STRIDE + (size_t)row * 512 + h * HD;
    const float ig = F.Gt[(size_t)row * 8 + h], lf = F.Gt[(size_t)row * 8 + 4 + h];
    const float q0 = bf2f(q[lane]), q1 = bf2f(q[lane + 64]), k0 = bf2f(k[lane]), k1 = bf2f(k[lane + 64]);
    const v2u vv = *(const v2u*)(v + v0); const float vj[4] = {bflo(vv.x), bfhi(vv.x), bflo(vv.y), bfhi(vv.y)};
    const float mn = fmaxf(lf + S.m, ig), a = __expf(lf + S.m - mn), bb = __expf(ig - mn); S.m = mn;
    float pn[4], pd;
    const float bk0 = bb * k0, bk1 = bb * k1;
#pragma unroll
    for (int j = 0; j < 4; ++j) { S.C[0][j] = a * S.C[0][j] + bk0 * vj[j]; S.C[1][j] = a * S.C[1][j] + bk1 * vj[j]; pn[j] = q0 * S.C[0][j] + q1 * S.C[1][j]; }
    S.n[0] = a * S.n[0] + bk0; S.n[1] = a * S.n[1] + bk1; pd = q0 * S.n[0] + q1 * S.n[1];
    if (write_h) {
#pragma unroll
        for (int j = 0; j < 4; ++j) pn[j] = wave_sum(pn[j]);
        pd = wave_sum(pd);
        const float den = fmaxf(fabsf(pd), __expf(-mn));
        if (lane == 0) { f32x4 o; o.x = pn[0] / den; o.y = pn[1] / den; o.z = pn[2] / den; o.w = pn[3] / den; *(f32x4*)(F.HRAW + (size_t)row * 512 + h * HD + v0) = o; }
    }
}
__device__ __forceinline__ void p2_mlstm_rec(Frame& F) {
    if (F.wave < 4) {
        for (int task = blockIdx.x * 4 + F.wave; task < NB * NH * 32; task += F.G * 4) {
            const int bh = task >> 5, vg = task & 31, b = bh >> 2, h = bh & 3, v0 = vg * 4;
            RecState S;
#pragma unroll
            for (int i = 0; i < 2; ++i) { S.n[i] = 0.f;
#pragma unroll
                for (int j = 0; j < 4; ++j) S.C[i][j] = 0.f; }
            S.m = 0.f;
            for (int t = 0; t < NMETA; ++t) rec_step(F, S, R_META0 + t, h, v0, F.lane, false);
            for (int t = 0; t < SEQ; ++t) rec_step(F, S, b * SEQ + t, h, v0, F.lane, true);
            float* Co = F.out + O_CP + (size_t)bh * HD * HD;
#pragma unroll
            for (int i = 0; i < 2; ++i) { f32x4 o; o.x = S.C[i][0]; o.y = S.C[i][1]; o.z = S.C[i][2]; o.w = S.C[i][3]; *(f32x4*)(Co + (size_t)(F.lane + 64 * i) * HD + v0) = o; }
            if (vg == 0) { F.out[O_NP + bh * HD + F.lane] = S.n[0]; F.out[O_NP + bh * HD + F.lane + 64] = S.n[1]; if (F.lane == 0) F.out[O_MP + bh] = S.m; }
        }
    } else {
        for (int task = blockIdx.x * 4 + (F.wave - 4); task < DECB * NH * 32; task += F.G * 4) {
            const int bh = task >> 5, vg = task & 31, b = bh >> 2, h = bh & 3, v0 = vg * 4;
            RecState S;
            const float* Ci = F.state_C + (size_t)bh * HD * HD;
#pragma unroll
            for (int i = 0; i < 2; ++i) { const f32x4 c = *(const f32x4*)(Ci + (size_t)(F.lane + 64 * i) * HD + v0); S.C[i][0] = c.x; S.C[i][1] = c.y; S.C[i][2] = c.z; S.C[i][3] = c.w; S.n[i] = F.state_n[bh * HD + F.lane + 64 * i]; }
            S.m = F.state_m[bh];
            for (int t = 0; t < DECT; ++t) rec_step(F, S, R_PROMPT + b * DECT + t, h, v0, F.lane, true);
            float* Co = F.out + O_CS + (size_t)bh * HD * HD;
#pragma unroll
            for (int i = 0; i < 2; ++i) { f32x4 o; o.x = S.C[i][0]; o.y = S.C[i][1]; o.z = S.C[i][2]; o.w = S.C[i][3]; *(f32x4*)(Co + (size_t)(F.lane + 64 * i) * HD + v0) = o; }
            if (vg == 0) { F.out[O_NS + bh * HD + F.lane] = S.n[0]; F.out[O_NS + bh * HD + F.lane + 64] = S.n[1]; if (F.lane == 0) F.out[O_MS + bh] = S.m; }
        }
    }
}

__device__ __forceinline__ float u_ext_val(const Frame& F, int row, int j, int c) {
    const bf16* U = F.P;
    if (row < R_PROMPT) { const int b = row >> 11, tr = (row & 2047) - j; const int r = tr >= 0 ? (b * SEQ + tr) : (R_META0 + NMETA + tr); return bf2f(U[(size_t)r * 512 + c]); }
    const int b = (row - R_PROMPT) >> 2, t = ((row - R_PROMPT) & 3) - j;
    if (t >= 0) return bf2f(U[(size_t)(R_PROMPT + b * DECT + t) * 512 + c]);
    return F.state_pool[((size_t)b * 15 + (15 + t)) * 512 + c];
}
__device__ __forceinline__ void p3_mix(Frame& F) {
    for (int task = F.gw; task < R_MAIN * NH; task += F.NGW) {
        const int row = task >> 2, h = task & 3;
        const f32x2 hv = *(const f32x2*)(F.HRAW + (size_t)row * 512 + h * HD + 2 * F.lane);
        const float rn = 1.f / sqrtf(wave_sum(hv.x * hv.x + hv.y * hv.y) * (1.f / HD) + EPS);
        const unsigned ow = *(const unsigned*)(F.P + 4 * P_STRIDE + (size_t)row * 512 + h * HD + 2 * F.lane);
        const f32x2 g = *(const f32x2*)(F.head_gain + h * HD + 2 * F.lane);
        *(unsigned*)(F.MIX + (size_t)row * D + PW + h * HD + 2 * F.lane) = pk2(hv.x * rn * g.x * sigmoidf_(bflo(ow)), hv.y * rn * g.y * sigmoidf_(bfhi(ow)));
    }
    LAS float* pl = (LAS float*)(F.lds + F.wave * 4096);
    for (int task = F.gw; task < (R_MAIN / 8) * 4; task += F.NGW) {
        const int tile = task >> 2, g = task & 3, w = 2 << g, row0 = tile * 8;
        const float inv = 1.f / (float)w;
        for (int t = 0; t < 8; ++t)
#pragma unroll
            for (int i = 0; i < 2; ++i) { const int c = g * 128 + F.lane + 64 * i; float s = 0.f; float u0 = 0.f;
                for (int j = 0; j < w; ++j) { const float uv = u_ext_val(F, row0 + t, j, c); s += uv; if (j == 0) u0 = uv; }
                pl[t * 128 + F.lane + 64 * i] = s * inv - u0; }
        LDS_WAIT(); asm volatile("" ::: "memory");
        float acc[8][2];
#pragma unroll
        for (int t = 0; t < 8; ++t) { acc[t][0] = 0.f; acc[t][1] = 0.f; }
        const float* wp = F.w_pool + (size_t)g * 128 * 128;
        for (int c = 0; c < 128; ++c) { const float w0 = wp[c * 128 + F.lane], w1 = wp[c * 128 + F.lane + 64];
#pragma unroll
            for (int t = 0; t < 8; ++t) { const float p = pl[t * 128 + c]; acc[t][0] += p * w0; acc[t][1] += p * w1; } }
        const float s0 = F.pool_scale[g * 128 + F.lane], s1 = F.pool_scale[g * 128 + F.lane + 64];
#pragma unroll
        for (int t = 0; t < 8; ++t) { bf16* mr = F.MIX + (size_t)(row0 + t) * D + g * 128; mr[F.lane] = (bf16)f2bf(acc[t][0] * s0); mr[F.lane + 64] = (bf16)f2bf(acc[t][1] * s1); }
        LDS_WAIT(); asm volatile("" ::: "memory");
    }
    const int gt = blockIdx.x * (NWAVES * 64) + F.tid, ngt = F.G * NWAVES * 64;
    for (int e = gt; e < NB * 15 * 512; e += ngt) { const int c = e & 511, i = (e >> 9) % 15, b = e / (15 * 512); F.out[O_POOLP + e] = bf2f(F.P[(size_t)(b * SEQ + SEQ - 15 + i) * 512 + c]); }
    for (int e = gt; e < DECB * 15 * 512; e += ngt) { const int c = e & 511, i = (e >> 9) % 15, b = e / (15 * 512);
        F.out[O_POOLS + e] = (i < 11) ? F.state_pool[((size_t)b * 15 + i + 4) * 512 + c] : bf2f(F.P[(size_t)(R_PROMPT + b * DECT + (i - 11)) * 512 + c]); }
}

__device__ __forceinline__ void p5_norm2(Frame& F) {
    for (int m = F.gw; m < R_MAIN; m += F.NGW) { f32x4 xn[4]; rms_row_to_bf16(F.out + O_Y + (size_t)m * D, F.norm2, F.XN + (size_t)m * D, F.lane, xn); }
}
__device__ __forceinline__ void p8_final(Frame& F) {
    for (int m = F.gw; m < R_MAIN; m += F.NGW) {
        GAS f32x4* xr = (GAS f32x4*)(F.out + O_Y + (size_t)m * D) + F.lane; const GAS f32x4* gr = (const GAS f32x4*)F.norm_f + F.lane;
        f32x4 v[4]; float s = 0.f;
#pragma unroll
        for (int j = 0; j < 4; ++j) { v[j] = xr[64 * j]; s += (v[j].x * v[j].x + v[j].y * v[j].y) + (v[j].z * v[j].z + v[j].w * v[j].w); }
        const float r = 1.f / sqrtf(wave_sum(s) * (1.f / D) + EPS);
#pragma unroll
        for (int j = 0; j < 4; ++j) xr[64 * j] = v[j] * r * gr[64 * j];
    }
}

struct Args { const float* in[18]; float* out; unsigned char* ws; int ph_lo, ph_hi; };
__global__ void __launch_bounds__(NWAVES * 64, 2) fwd_kernel(Args args) {
    extern __shared__ __attribute__((aligned(16))) unsigned char lds[];
    Frame F;
    F.lds = (LAS unsigned char*)lds;
    F.tid = threadIdx.x; F.lane = F.tid & 63; F.wave = __builtin_amdgcn_readfirstlane(F.tid >> 6);
    F.G = gridDim.x; F.gw = blockIdx.x * NWAVES + F.wave; F.NGW = F.G * NWAVES;
    F.x_prompt = args.in[0]; F.x_sample = args.in[1]; F.state_pool = args.in[2]; F.state_C = args.in[3]; F.state_n = args.in[4]; F.state_m = args.in[5]; F.meta = args.in[6]; F.norm1 = args.in[7];
    F.w_in = args.in[8]; F.b_gate = args.in[9]; F.w_pool = args.in[10]; F.pool_scale = args.in[11]; F.head_gain = args.in[12]; F.w_out = args.in[13]; F.norm2 = args.in[14]; F.w_up = args.in[15];
    F.w_down = args.in[16]; F.norm_f = args.in[17]; F.out = args.out;
    unsigned char* ws = args.ws;
    F.Win_t = (bf16*)(ws + WS_WIN); F.Wout_t = (bf16*)(ws + WS_WOUT); F.Wup_t = (bf16*)(ws + WS_WUP); F.Wdn_t = (bf16*)(ws + WS_WDN);
    F.Gt = (float*)(ws + WS_G); F.XN = (bf16*)(ws + WS_XN); F.P = (bf16*)(ws + WS_P); F.MIX = (bf16*)(ws + WS_MIX); F.HRAW = (float*)(ws + WS_HRAW); F.H = (bf16*)(ws + WS_H);
    const int lo = args.ph_lo, hi = args.ph_hi;
#define IN(k) (lo <= (k) && (k) < hi)
    if (IN(0)) { p0_prologue(F); }
    if (IN(1)) { pg8::Gemm g{F.XN, F.Win_t, M_IN, NIN, D}; pg8::StaticOrder S; S.init(M_IN, NIN, F.G, (int)blockIdx.x);
        pg8::EpiIn E{F.P, P_STRIDE, 0.08838834764831845f};
        pg8::gemm_phase<pg8::EpiIn, pg8::StaticOrder, PG8_ALIGN, PG8_SP2>(F.lds, g, S, E); }
    if (IN(2)) { p2_mlstm_rec(F); }
    if (IN(3)) { p3_mix(F); }
    if (IN(4)) { pg8::Gemm g{F.MIX, F.Wout_t, R_MAIN, D, D}; pg8::StaticOrder S; S.init(R_MAIN, D, F.G, (int)blockIdx.x);
        pg8::EpiRes E{F.x_prompt, F.x_sample, R_PROMPT / 256, F.out + O_Y};
        pg8::gemm_phase<pg8::EpiRes, pg8::StaticOrder, PG8_ALIGN, PG8_SP2>(F.lds, g, S, E); }
    if (IN(5)) { p5_norm2(F); }
    if (IN(6)) { pg8::Gemm g{F.XN, F.Wup_t, R_MAIN, FF, D}; pg8::StaticOrder S; S.init(R_MAIN, FF, F.G, (int)blockIdx.x);
        pg8::EpiRelu2 E{F.H, FF};
        pg8::gemm_phase<pg8::EpiRelu2, pg8::StaticOrder, PG8_ALIGN, PG8_SP2>(F.lds, g, S, E); }
    if (IN(7)) { pg8::Gemm g{F.H, F.Wdn_t, R_MAIN, D, FF}; pg8::StaticOrder S; S.init(R_MAIN, D, F.G, (int)blockIdx.x);
        pg8::EpiRes E{F.out + O_Y, F.out + O_Y, 1 << 20, F.out + O_Y};
        pg8::gemm_phase<pg8::EpiRes, pg8::StaticOrder, PG8_ALIGN, PG8_SP2>(F.lds, g, S, E); }
    if (IN(8)) { p8_final(F); }
#undef IN
}

extern "C" void kernel_launch(void* const* d_in, const int* in_sizes, int n_in, void* d_out, int out_size, void* d_ws, size_t ws_size, hipStream_t stream) {
    static int grid = 0;
    if (grid == 0) {
        if (n_in != 18 || out_size != (int)O_END || ws_size < WS_END) { fprintf(stderr, "kernel_launch: unexpected shapes n_in %d out %d ws %zu\n", n_in, out_size, ws_size); grid = -1; return; }
        int dev = 0, cus = 0;
        if (hipGetDevice(&dev) != hipSuccess || hipDeviceGetAttribute(&cus, hipDeviceAttributeMultiprocessorCount, dev) != hipSuccess) { grid = -1; return; }
        if (hipFuncSetAttribute((const void*)fwd_kernel, hipFuncAttributeMaxDynamicSharedMemorySize, LDS_BYTES) != hipSuccess) { fprintf(stderr, "kernel_launch: hipFuncSetAttribute failed\n"); grid = -1; return; }
        grid = cus;
    }
    if (grid < 0) return;
    Args a{};
    for (int i = 0; i < 18; ++i) a.in[i] = (const float*)d_in[i];
    a.out = (float*)d_out; a.ws = (unsigned char*)d_ws;
    for (int ph = 0; ph < 9; ++ph) { a.ph_lo = ph; a.ph_hi = ph + 1; hipLaunchKernelGGL(fwd_kernel, dim3(grid), dim3(NWAVES * 64), LDS_BYTES, stream, a); }
}
```

```cpp
#include <hip/hip_runtime.h>
#include <cstdio>
#include <cstdint>
namespace pg8 {
#define PG8_LAS __attribute__((address_space(3)))
typedef unsigned short bf16_t;
typedef short bf16x8 __attribute__((ext_vector_type(8)));
typedef float f32x4 __attribute__((ext_vector_type(4)));
typedef unsigned u32x4 __attribute__((ext_vector_type(4)));
constexpr int BM = 256, BK = 64, HALF = 128, HTB = HALF * BK * 2  , STAGE_BYTES = 8 * HTB, NXCD = 8, WGM = 8;

__host__ __device__ __forceinline__ int lds_byte(int r, int c) { const int st = (r >> 4) * 2 + (c >> 5), rr = r & 15, cc = c & 31, ob = rr * 64 + cc * 2; return st * 1024 + (ob ^ (((ob >> 9) & 1) << 5)); }
__host__ __device__ __forceinline__ void stage_rc(int b, int& R, int& C) { const int st = b / 1024, sb = b % 1024, swz = sb ^ (((sb >> 9) & 1) << 5); R = (st >> 1) * 16 + swz / 64; C = (st & 1) * 32 + (swz % 64) / 2; }
__host__ __device__ __forceinline__ int perm32(int rho) { const int n = rho >> 4, i = rho & 15; return 8 * (i >> 2) + 4 * n + (i & 3); }

struct Unit { int pm, pn; };
struct Gemm { const bf16_t* A; const bf16_t* Bt; int M, N, K; };

struct StaticOrder {
    int nM, nN, nwg, G, c;
    __host__ __device__ void init(int M, int N, int G_, int c_) { nM = M / BM; nN = N / BM; nwg = nM * nN; G = G_; c = c_; }
    __host__ __device__ bool next(int i, Unit& u) const {
        const long L = (long)i * G + c; if (L >= nwg) return false;
        int wgid = (int)L; { const int q = nwg / NXCD, r = nwg % NXCD, xcd = wgid % NXCD, off = wgid / NXCD; wgid = (xcd < r ? xcd * (q + 1) : r * (q + 1) + (xcd - r) * q) + off; }
        const int nig = WGM * nN, gid = wgid / nig, fm = gid * WGM, gsz = (nM - fm) < WGM ? (nM - fm) : WGM;
        u.pm = fm + ((wgid % nig) % gsz); u.pn = (wgid % nig) / gsz; return true;
    }
    __device__ __forceinline__ void a_ready(const Unit&) const {}
    __device__ __forceinline__ void done(const Unit&) const {}
};

__device__ __forceinline__ unsigned cvt_pk_bf16(float lo, float hi) { unsigned r; asm volatile("v_cvt_pk_bf16_f32 %0, %1, %2" : "=v"(r) : "v"(lo), "v"(hi)); return r; }

struct EpiIn {
    static constexpr bool PERM = true, AFTER_DRAIN = false;
    bf16_t* O; size_t split_stride; float qscale;
    __device__ __forceinline__ void operator()(const f32x4 (&acc)[2][2][4][2], const Unit& u, int wr, int wc, int fr, int fq) const {
        const int row0 = u.pm * BM + wr * 64 + fr; const int t = u.pn >> 1; const int colt = (u.pn & 1) * BM;
        bf16_t* base = O + (size_t)t * split_stride; const float sc = (t == 1) ? qscale : 1.f;
        const int col0 = colt + wc * 32 + 8 * fq;
#pragma unroll
        for (int ai = 0; ai < 2; ++ai)
#pragma unroll
            for (int m = 0; m < 4; ++m) { bf16_t* rowp = base + (size_t)(row0 + ai * HALF + m * 16) * 512 + col0;
#pragma unroll
                for (int bj = 0; bj < 2; ++bj) { f32x4 v0 = acc[ai][bj][m][0] * sc, v1 = acc[ai][bj][m][1] * sc;
                    u32x4 w; w.x = cvt_pk_bf16(v0[0], v0[1]); w.y = cvt_pk_bf16(v0[2], v0[3]); w.z = cvt_pk_bf16(v1[0], v1[1]); w.w = cvt_pk_bf16(v1[2], v1[3]);
                    *(u32x4*)(rowp + bj * HALF) = w; } }
    }
};
struct EpiRelu2 {
    static constexpr bool PERM = true, AFTER_DRAIN = false;
    bf16_t* O; int ldc;
    __device__ __forceinline__ void operator()(const f32x4 (&acc)[2][2][4][2], const Unit& u, int wr, int wc, int fr, int fq) const {
        const int row0 = u.pm * BM + wr * 64 + fr; const int col0 = u.pn * BM + wc * 32 + 8 * fq;
#pragma unroll
        for (int ai = 0; ai < 2; ++ai)
#pragma unroll
            for (int m = 0; m < 4; ++m) { bf16_t* rowp = O + (size_t)(row0 + ai * HALF + m * 16) * ldc + col0;
#pragma unroll
                for (int bj = 0; bj < 2; ++bj) { f32x4 v0 = acc[ai][bj][m][0], v1 = acc[ai][bj][m][1];
#pragma unroll
                    for (int e = 0; e < 4; ++e) { const float a = fmaxf(v0[e], 0.f), b = fmaxf(v1[e], 0.f); v0[e] = a * a; v1[e] = b * b; }
                    u32x4 w; w.x = cvt_pk_bf16(v0[0], v0[1]); w.y = cvt_pk_bf16(v0[2], v0[3]); w.z = cvt_pk_bf16(v1[0], v1[1]); w.w = cvt_pk_bf16(v1[2], v1[3]);
                    *(u32x4*)(rowp + bj * HALF) = w; } }
    }
};
struct EpiRes {
    static constexpr bool PERM = false, AFTER_DRAIN = false;
    const float* resA; const float* resB; int split_pm; float* out;
    __device__ __forceinline__ void operator()(const f32x4 (&acc)[2][2][4][2], const Unit& u, int wr, int wc, int fr, int fq) const {
        const int row0 = u.pm * BM + wr * 64 + fr, col0 = u.pn * BM + wc * 32 + 4 * fq;
        const float* res = (u.pm < split_pm) ? resA : (resB - (size_t)split_pm * BM * 1024);
#pragma unroll
        for (int ai = 0; ai < 2; ++ai)
#pragma unroll
            for (int m = 0; m < 4; ++m) { const size_t off = (size_t)(row0 + ai * HALF + m * 16) * 1024 + col0;
#pragma unroll
                for (int bj = 0; bj < 2; ++bj)
#pragma unroll
                    for (int n = 0; n < 2; ++n) { const f32x4 r = *(const f32x4*)(res + off + bj * HALF + n * 16); *(f32x4*)(out + off + bj * HALF + n * 16) = r + acc[ai][bj][m][n]; } }
    }
};

template <class Epi, class Sched, bool ALIGN_EPI = false, bool SP2 = false>
__device__ __forceinline__ void gemm_phase(PG8_LAS unsigned char* lds, const Gemm g, const Sched& S, const Epi& E) {
    const int tid = threadIdx.x, wid = __builtin_amdgcn_readfirstlane(tid >> 6), lane = tid & 63, wr = wid >> 2, wc = wid & 3, fr = lane & 15, fq = lane >> 4;
    const int K = g.K, nt = K / BK;
    unsigned voffA[2], voffB[2];
#pragma unroll
    for (int i = 0; i < 2; ++i) { int R, C; stage_rc(tid * 16 + i * 8192, R, C); const int Rb = Epi::PERM ? ((R & ~31) + perm32(R & 31)) : R;
        voffA[i] = (unsigned)(R * K + C) * 2u; voffB[i] = (unsigned)(Rb * K + C) * 2u; }
    const size_t kstep = (size_t)(BK * 2);
    const size_t hstep = (size_t)HALF * K * 2;
    const size_t tstep = 2 * hstep;
    const unsigned ldsw = (unsigned)wid * 1024u;
    const int aoff = lds_byte(wr * 64 + fr, fq * 8), boff = lds_byte(wc * 32 + fr, fq * 8);
#define PG8_SA(b, h) (((b) * 2 + (h)) * HTB)
#define PG8_SB(b, h) ((4 + (b) * 2 + (h)) * HTB)
#define PG8_STAGE(bufoff, gbase, voff) do { _Pragma("unroll") for (int _i = 0; _i < 2; ++_i) \
        __builtin_amdgcn_global_load_lds((const unsigned*)((const char*)(gbase) + (voff)[_i]), (PG8_LAS unsigned*)(lds + (bufoff) + ldsw + _i * 8192), 16, 0, 0); } while (0)
#define PG8_LDA(dst, b, h) do { _Pragma("unroll") for (int m = 0; m < 4; ++m) _Pragma("unroll") for (int k = 0; k < 2; ++k) dst[m][k] = *(const PG8_LAS bf16x8*)(lds + PG8_SA(b, h) + aoff + m * 2048 + k * 1024); } while (0)
#define PG8_LDB(dst, b, h) do { _Pragma("unroll") for (int n = 0; n < 2; ++n) _Pragma("unroll") for (int k = 0; k < 2; ++k) dst[n][k] = *(const PG8_LAS bf16x8*)(lds + PG8_SB(b, h) + boff + n * 2048 + k * 1024); } while (0)
#define PG8_MMA(ai, bj, At, Bt) do { __builtin_amdgcn_s_setprio(1); _Pragma("unroll") for (int m = 0; m < 4; ++m) _Pragma("unroll") for (int n = 0; n < 2; ++n) _Pragma("unroll") for (int k = 0; k < 2; ++k) \
        acc[ai][bj][m][n] = __builtin_amdgcn_mfma_f32_16x16x32_bf16(Bt[n][k], At[m][k], acc[ai][bj][m][n], 0, 0, 0); __builtin_amdgcn_s_setprio(0); } while (0)
#define PG8_WAIT_V(n) asm volatile("s_waitcnt vmcnt(" #n ")" ::: "memory")
#define PG8_WAIT_L(n) asm volatile("s_waitcnt lgkmcnt(" #n ")" ::: "memory")
#define PG8_BAR __builtin_amdgcn_s_barrier()
#define PG8_SCHED __builtin_amdgcn_sched_barrier(0)
    Unit cur, nxt; int ui = 0;
    if (!S.next(0, cur)) return;
    f32x4 acc[2][2][4][2];
#pragma unroll
    for (int a = 0; a < 2; ++a)
#pragma unroll
        for (int b = 0; b < 2; ++b)
#pragma unroll
            for (int m = 0; m < 4; ++m)
#pragma unroll
                for (int n = 0; n < 2; ++n) acc[a][b][m][n] = (f32x4){0.f, 0.f, 0.f, 0.f};
    bf16x8 At[4][2], B0[2][2], B1[2][2];
    const char* cA = (const char*)g.A + (size_t)cur.pm * tstep; const char* cB = (const char*)g.Bt + (size_t)cur.pn * tstep;
    S.a_ready(cur);
    if constexpr (SP2) {
        PG8_STAGE(PG8_SB(0, 0), cB, voffB); PG8_STAGE(PG8_SB(0, 1), cB + hstep, voffB); PG8_STAGE(PG8_SA(0, 0), cA, voffA); PG8_STAGE(PG8_SA(0, 1), cA + hstep, voffA);
        if (wr == 1) PG8_BAR;
        PG8_WAIT_V(2); PG8_BAR;
        PG8_STAGE(PG8_SB(1, 0), cB + kstep, voffB); PG8_STAGE(PG8_SA(1, 0), cA + kstep, voffA); PG8_STAGE(PG8_SB(1, 1), cB + hstep + kstep, voffB);
        PG8_WAIT_V(6); PG8_BAR;
    } else {
        PG8_STAGE(PG8_SB(0, 0), cB, voffB); PG8_STAGE(PG8_SA(0, 0), cA, voffA); PG8_STAGE(PG8_SB(0, 1), cB + hstep, voffB); PG8_STAGE(PG8_SA(0, 1), cA + hstep, voffA);
        if (wr == 1) PG8_BAR;
        PG8_WAIT_V(4); PG8_BAR;
        PG8_STAGE(PG8_SB(1, 0), cB + kstep, voffB); PG8_STAGE(PG8_SA(1, 0), cA + kstep, voffA); PG8_STAGE(PG8_SB(1, 1), cB + hstep + kstep, voffB);
        PG8_WAIT_V(6); PG8_BAR;
    }
    for (;;) {
        const bool has_next = S.next(ui + 1, nxt);
        const char* nA = has_next ? (const char*)g.A + (size_t)nxt.pm * tstep : cA; const char* nB = has_next ? (const char*)g.Bt + (size_t)nxt.pn * tstep : cB;
        for (int t = 0; t < nt; t += 2) {
            const bool last = (t == nt - 2);
            const char* a1 = cA + (size_t)(t + 1) * kstep;
            const char* a2 = last ? nA : cA + (size_t)(t + 2) * kstep; const char* b2 = last ? nB : cB + (size_t)(t + 2) * kstep;
            const char* a3 = a2 + kstep; const char* b3 = b2 + kstep;
            if (last && has_next) S.a_ready(nxt);
            if constexpr (SP2) {
            PG8_LDB(B0, 0, 0); PG8_LDB(B1, 0, 1); PG8_SCHED; PG8_LDA(At, 0, 0); PG8_STAGE(PG8_SA(1, 1), a1 + hstep, voffA);
            PG8_WAIT_V(8); PG8_WAIT_L(0); PG8_BAR; PG8_MMA(0, 0, At, B0); PG8_MMA(0, 1, At, B1); PG8_BAR; PG8_SCHED;
            PG8_LDA(At, 0, 1); PG8_STAGE(PG8_SB(0, 0), b2, voffB); PG8_STAGE(PG8_SB(0, 1), b2 + hstep, voffB); PG8_STAGE(PG8_SA(0, 0), a2, voffA);
            PG8_WAIT_V(8); PG8_WAIT_L(0); PG8_BAR; PG8_MMA(1, 0, At, B0); PG8_MMA(1, 1, At, B1); PG8_BAR; PG8_SCHED;
            PG8_LDB(B0, 1, 0); PG8_LDB(B1, 1, 1); PG8_SCHED; PG8_LDA(At, 1, 0); PG8_STAGE(PG8_SA(0, 1), a2 + hstep, voffA);
            PG8_WAIT_V(8); PG8_WAIT_L(0); PG8_BAR; PG8_MMA(0, 0, At, B0); PG8_MMA(0, 1, At, B1); PG8_BAR; PG8_SCHED;
            PG8_LDA(At, 1, 1); PG8_STAGE(PG8_SB(1, 0), b3, voffB); PG8_STAGE(PG8_SB(1, 1), b3 + hstep, voffB); PG8_STAGE(PG8_SA(1, 0), a3, voffA);
            PG8_WAIT_V(8); PG8_WAIT_L(0); PG8_BAR; PG8_MMA(1, 0, At, B0); PG8_MMA(1, 1, At, B1); PG8_BAR; PG8_SCHED;
            } else {
            PG8_LDB(B0, 0, 0); PG8_SCHED; PG8_LDA(At, 0, 0); PG8_STAGE(PG8_SA(1, 1), a1 + hstep, voffA);
            PG8_WAIT_L(8); PG8_BAR; PG8_WAIT_L(0); PG8_MMA(0, 0, At, B0); PG8_BAR; PG8_SCHED;
            PG8_LDB(B1, 0, 1); PG8_STAGE(PG8_SB(0, 0), b2, voffB);
            PG8_BAR; PG8_WAIT_L(0); PG8_MMA(0, 1, At, B1); PG8_BAR;
            PG8_LDA(At, 0, 1); PG8_STAGE(PG8_SA(0, 0), a2, voffA);
            PG8_BAR; PG8_WAIT_L(0); PG8_MMA(1, 0, At, B0); PG8_BAR; PG8_SCHED;
            PG8_STAGE(PG8_SB(0, 1), b2 + hstep, voffB);
            PG8_WAIT_V(6); PG8_BAR; PG8_MMA(1, 1, At, B1); PG8_BAR;
            PG8_LDB(B0, 1, 0); PG8_SCHED; PG8_LDA(At, 1, 0); PG8_STAGE(PG8_SA(0, 1), a2 + hstep, voffA);
            PG8_WAIT_L(8); PG8_BAR; PG8_WAIT_L(0); PG8_MMA(0, 0, At, B0); PG8_BAR; PG8_SCHED;
            PG8_LDB(B1, 1, 1); PG8_STAGE(PG8_SB(1, 0), b3, voffB);
            PG8_BAR; PG8_WAIT_L(0); PG8_MMA(0, 1, At, B1); PG8_BAR;
            PG8_LDA(At, 1, 1); PG8_STAGE(PG8_SA(1, 0), a3, voffA);
            PG8_BAR; PG8_WAIT_L(0); PG8_MMA(1, 0, At, B0); PG8_BAR; PG8_SCHED;
            PG8_STAGE(PG8_SB(1, 1), b3 + hstep, voffB);
            PG8_WAIT_V(6); PG8_BAR; PG8_MMA(1, 1, At, B1); PG8_BAR;
            }
        }
        if constexpr (ALIGN_EPI) { if (wr == 0) PG8_BAR; }
        if constexpr (!Epi::AFTER_DRAIN) { E(acc, cur, wr, wc, fr, fq); S.done(cur); }
        if (!has_next) break;
#pragma unroll
        for (int a = 0; a < 2; ++a)
#pragma unroll
            for (int b = 0; b < 2; ++b)
#pragma unroll
                for (int m = 0; m < 4; ++m)
#pragma unroll
                    for (int n = 0; n < 2; ++n) acc[a][b][m][n] = (f32x4){0.f, 0.f, 0.f, 0.f};
        cur = nxt; cA = nA; cB = nB; ++ui;
        if constexpr (ALIGN_EPI) { if (wr == 1) PG8_BAR; }
    }
    PG8_WAIT_V(0);
    if constexpr (!ALIGN_EPI) { if (wr == 0) PG8_BAR; }
    PG8_BAR;
    if constexpr (Epi::AFTER_DRAIN) { E.fused(acc, cur, wr, wc, fr, fq, lds, wid, lane); S.done(cur); }
#undef PG8_SA
#undef PG8_SB
#undef PG8_STAGE
#undef PG8_LDA
#undef PG8_LDB
#undef PG8_MMA
#undef PG8_WAIT_V
#undef PG8_WAIT_L
#undef PG8_BAR
#undef PG8_SCHED
}
}
#ifndef PG8_SP2
#define PG8_SP2 true
#endif
#ifndef PG8_ALIGN
#define PG8_ALIGN true
#endif
constexpr int NWAVES = 8;
constexpr int D = 1024, NB = 8, SEQ = 2048, DECB = 128, DECT = 4, NMETA = 16;
constexpr int PW = 512, NH = 4, HD = 128, FF = 4096, INC = 2568, NIN = 2560;
constexpr int R_PROMPT = NB * SEQ;
constexpr int R_SAMPLE = DECB * DECT;
constexpr int R_MAIN = R_PROMPT + R_SAMPLE;
constexpr int R_META0 = R_MAIN;
constexpr int R_IN = R_MAIN + NMETA;
constexpr int M_IN = 17152;
constexpr int LP = SEQ + NMETA;
constexpr float EPS = 1e-6f;
constexpr size_t MiB = 1u << 20;
constexpr size_t WS_CTL = 0, CTL_ZERO_BYTES = 1 * MiB;
constexpr int CW_BAR = 4096;
constexpr size_t WS_WIN = 1 * MiB, WS_WOUT = 6 * MiB, WS_WUP = 8 * MiB, WS_WDN = 16 * MiB;
constexpr size_t WS_G = 24 * MiB;
constexpr size_t WS_XN = 25 * MiB;
constexpr size_t WS_P = 59 * MiB;
constexpr size_t P_STRIDE = (size_t)M_IN * 512;
constexpr size_t WS_MIX = 143 * MiB;
constexpr size_t WS_HRAW = 176 * MiB;
constexpr size_t WS_H = 59 * MiB;
constexpr size_t WS_END = 209 * MiB;
static_assert(WS_P + 5 * P_STRIDE * 2 <= WS_MIX && WS_MIX + (size_t)R_MAIN * 1024 * 2 <= WS_HRAW && WS_HRAW + (size_t)R_MAIN * 512 * 4 <= WS_END && WS_H + (size_t)R_MAIN * FF * 2 <= WS_END, "d_ws map");
constexpr size_t O_Y = 0, O_POOLP = 17301504, O_CP = 17362944, O_NP = 17887232, O_MP = 17891328, O_POOLS = 17891360, O_CS = 18874400, O_NS = 27263008, O_MS = 27328544, O_END = 27329056;
constexpr int RING_BYTES = 131072, LDS_BYTES = 147456, MISC_OFF = RING_BYTES + 320;

#define GAS __attribute__((address_space(1)))
#define LAS __attribute__((address_space(3)))
typedef unsigned short bf16;
typedef unsigned v4u __attribute__((ext_vector_type(4)));
typedef unsigned v2u __attribute__((ext_vector_type(2)));
typedef float f32x4 __attribute__((ext_vector_type(4)));
typedef float f32x2 __attribute__((ext_vector_type(2)));
#define LDS_WAIT() asm volatile("s_waitcnt lgkmcnt(0)" ::: "memory")
#define VM_WAIT() asm volatile("s_waitcnt vmcnt(0)" ::: "memory")
__device__ __forceinline__ unsigned f2bf(float f) { unsigned u = __builtin_bit_cast(unsigned, f); return (u + 0x7fffu + ((u >> 16) & 1u)) >> 16; }
__device__ __forceinline__ unsigned pk2(float lo, float hi) { return f2bf(lo) | (f2bf(hi) << 16); }
__device__ __forceinline__ float bf2f(unsigned short b) { return __builtin_bit_cast(float, (unsigned)b << 16); }
__device__ __forceinline__ float bflo(unsigned w) { return __builtin_bit_cast(float, w << 16); }
__device__ __forceinline__ float bfhi(unsigned w) { return __builtin_bit_cast(float, w & 0xffff0000u); }
__device__ __forceinline__ float wave_sum(float v) {
#pragma unroll
    for (int o = 1; o < 64; o <<= 1) v += __shfl_xor(v, o);
    return v;
}
__device__ __forceinline__ float sigmoidf_(float x) { return 1.f / (1.f + __expf(-x)); }
__device__ __forceinline__ float logsigmoidf_(float x) { return fminf(x, 0.f) - log1pf(expf(-fabsf(x))); }

#define XB_TMO      128
#define XB_XCNT(j)  (256  + 64 * (j))
#define XB_XSUB(j)  (1280 + 64 * (j))
#define XB_XGEN(j)  (2304 + 64 * (j))
#define XB_TOP      3328
#define XB_TOPGEN   3392
#define XCD_BAR_WORDS 3456
#define XB_SPIN_CAP (1u << 18)

__device__ __forceinline__ unsigned xb_ld(unsigned* p)              { return __hip_atomic_load(p, __ATOMIC_RELAXED, __HIP_MEMORY_SCOPE_AGENT); }
__device__ __forceinline__ unsigned xb_add(unsigned* p, unsigned v) { return __hip_atomic_fetch_add(p, v, __ATOMIC_RELAXED, __HIP_MEMORY_SCOPE_AGENT); }
__device__ __forceinline__ unsigned xb_xcc_id() { return (unsigned)__builtin_amdgcn_s_getreg((3 << 11) | 20) & 0xFu; }
#define XB_SPIN(cond, bar) do { unsigned _sp = 0; while (cond) { __builtin_amdgcn_s_sleep(1); \
    if ((++_sp & 255u) == 0u) { if (xb_ld(&(bar)[XB_TMO])) break; if (_sp > XB_SPIN_CAP) { atomicAdd(&(bar)[XB_TMO], 1u); break; } } } } while (0)

struct XcdBarrier {
    unsigned* bar; unsigned x;
    volatile LAS unsigned* st;
};

__device__ __forceinline__ XcdBarrier xcd_barrier_post(unsigned* bar, volatile LAS unsigned* st) {
    XcdBarrier b; b.bar = bar; b.x = xb_xcc_id(); b.st = st;
    if (threadIdx.x == 0) (void)xb_add(&bar[XB_XCNT(b.x)], 1u);
    return b;
}
__device__ __forceinline__ void xcd_barrier_complete(unsigned* bar, unsigned x, unsigned& nloc, unsigned& nx) {
    const unsigned G = gridDim.x * gridDim.y * gridDim.z;
    unsigned sum, cnt, mine, sp = 0u;
    for (;;) {
        sum = 0u; cnt = 0u; mine = 0u;
#pragma unroll
        for (unsigned j = 0; j < 16; ++j) { const unsigned c = xb_ld(&bar[XB_XCNT(j)]); sum += c; cnt += (c > 0u) ? 1u : 0u; mine = (j == x) ? c : mine; }
        if (sum == G) break;
        __builtin_amdgcn_s_sleep(1);
        if ((++sp & 255u) == 0u) { if (xb_ld(&bar[XB_TMO])) break; if (sp > XB_SPIN_CAP) { atomicAdd(&bar[XB_TMO], 1u); break; } }
    }
    nloc = mine > 0u ? mine : 1u; nx = cnt > 0u ? cnt : 1u;
}

__device__ __forceinline__ void xcd_barrier(const XcdBarrier& b) {
    asm volatile("s_waitcnt vmcnt(0)" ::: "memory");
    __syncthreads();
    if (threadIdx.x == 0) {
        unsigned* bar = b.bar;
        __builtin_amdgcn_s_waitcnt(0);
        unsigned nloc = b.st[0], nx = b.st[1];
        if (nloc == 0u) { xcd_barrier_complete(bar, b.x, nloc, nx); b.st[0] = nloc; b.st[1] = nx; }
        const unsigned old = xb_add(&bar[XB_XSUB(b.x)], 1u);
        const unsigned gen = old / nloc;
        if (old + 1u == (gen + 1u) * nloc) {
            __builtin_amdgcn_fence(__ATOMIC_RELEASE, "agent");
            asm volatile("s_waitcnt vmcnt(0)" ::: "memory");
            const unsigned og = xb_add(&bar[XB_TOP], 1u);
            const unsigned tg = og / nx;
            if (og + 1u == (tg + 1u) * nx) xb_add(&bar[XB_TOPGEN], 1u);
            else XB_SPIN(xb_ld(&bar[XB_TOPGEN]) == tg, bar);
            __builtin_amdgcn_fence(__ATOMIC_ACQUIRE, "agent");
            xb_add(&bar[XB_XGEN(b.x)], 1u);
            asm volatile("s_waitcnt vmcnt(0)" ::: "memory");
        } else {
            XB_SPIN(xb_ld(&bar[XB_XGEN(b.x)]) == gen, bar);
            __builtin_amdgcn_fence(__ATOMIC_ACQUIRE, "agent");
            asm volatile("s_waitcnt vmcnt(0)" ::: "memory");
        }
    }
    __syncthreads();
}

struct Frame {
    LAS unsigned char* lds;
    int tid, lane, wave, G, gw, NGW;
    const float *x_prompt, *x_sample, *state_pool, *state_C, *state_n, *state_m, *meta, *norm1, *w_in, *b_gate, *w_pool, *pool_scale, *head_gain, *w_out, *norm2, *w_up, *w_down, *norm_f;
    float* out;
    bf16 *Win_t, *Wout_t, *Wup_t, *Wdn_t, *XN, *P, *MIX, *H;
    float *Gt, *HRAW;
};

__device__ __forceinline__ void p0_transpose_item(const float* W, int K, int ldw, int ncols, bf16* WT, LAS float* scr, int item, int lane) {
    const int nblk = ncols / 32, kb = item / nblk, nb = item % nblk, k0 = 64 * kb, n0 = 32 * nb;
#pragma unroll 8
    for (int i = 0; i < 32; ++i) { const int kk = 2 * i + (lane >> 5); scr[kk * 33 + (lane & 31)] = W[(size_t)(k0 + kk) * ldw + n0 + (lane & 31)]; }
    LDS_WAIT(); asm volatile("" ::: "memory");
    const int c = lane & 7;
#pragma unroll
    for (int j = 0; j < 4; ++j) { const int n = (lane >> 3) + 8 * j; const LAS float* s = scr + (8 * c) * 33 + n;
        v4u o; o.x = pk2(s[0 * 33], s[1 * 33]); o.y = pk2(s[2 * 33], s[3 * 33]); o.z = pk2(s[4 * 33], s[5 * 33]); o.w = pk2(s[6 * 33], s[7 * 33]);
        *(GAS v4u*)(WT + (size_t)(n0 + n) * K + k0 + 8 * c) = o; }
    LDS_WAIT(); asm volatile("" ::: "memory");
}
__device__ __forceinline__ const float* in_row_ptr(const Frame& F, int r) {
    return r < R_PROMPT ? F.x_prompt + (size_t)r * D : (r < R_MAIN ? F.x_sample + (size_t)(r - R_PROMPT) * D : F.meta + (size_t)(r - R_META0) * D);
}
__device__ __forceinline__ void rms_row_to_bf16(const float* xrow, const float* g, bf16* orow, int lane, f32x4 (&xn)[4]) {
    const GAS f32x4* xr = (const GAS f32x4*)xrow + lane; const GAS f32x4* gr = (const GAS f32x4*)g + lane;
    float s = 0.f;
#pragma unroll
    for (int j = 0; j < 4; ++j) { xn[j] = xr[64 * j]; s += (xn[j].x * xn[j].x + xn[j].y * xn[j].y) + (xn[j].z * xn[j].z + xn[j].w * xn[j].w); }
    const float r = 1.f / sqrtf(wave_sum(s) * (1.f / D) + EPS);
    GAS v2u* o8 = (GAS v2u*)orow + lane;
#pragma unroll
    for (int j = 0; j < 4; ++j) { xn[j] = xn[j] * r * gr[64 * j]; v2u w; w.x = pk2(xn[j].x, xn[j].y); w.y = pk2(xn[j].z, xn[j].w); o8[64 * j] = w; }
}
__device__ __forceinline__ void p0_prologue(Frame& F) {
    LAS float* scr = (LAS float*)(F.lds + F.wave * 8448);
    LAS float* wgL = (LAS float*)(F.lds + 69632);
    for (int e = F.tid; e < 8 * D; e += NWAVES * 64) { const int g = e >> 10, k = e & 1023; wgL[e] = F.w_in[(size_t)k * INC + NIN + g]; }
    constexpr int I_IN = (D / 64) * (NIN / 32), I_OUT = (D / 64) * (D / 32), I_UP = (D / 64) * (FF / 32), I_DN = (FF / 64) * (D / 32);
    constexpr int NITEMS = I_IN + I_OUT + I_UP + I_DN;
    for (int it = F.gw; it < NITEMS; it += F.NGW) {
        int r = it;
        if (r < I_IN) { p0_transpose_item(F.w_in, D, INC, NIN, F.Win_t, scr, r, F.lane); continue; } r -= I_IN;
        if (r < I_OUT) { p0_transpose_item(F.w_out, D, D, D, F.Wout_t, scr, r, F.lane); continue; } r -= I_OUT;
        if (r < I_UP) { p0_transpose_item(F.w_up, D, FF, FF, F.Wup_t, scr, r, F.lane); continue; } r -= I_UP;
        p0_transpose_item(F.w_down, FF, D, D, F.Wdn_t, scr, r, F.lane);
    }
    __syncthreads();
    for (int m = F.gw; m < M_IN; m += F.NGW) {
        bf16* orow = F.XN + (size_t)m * D;
        if (m >= R_IN) { GAS v2u* o8 = (GAS v2u*)orow + F.lane; v2u z; z.x = 0u; z.y = 0u;
#pragma unroll
            for (int j = 0; j < 4; ++j) o8[64 * j] = z;
            if (F.lane < 8) F.Gt[(size_t)m * 8 + F.lane] = 0.f;
            continue; }
        f32x4 xn[4];
        rms_row_to_bf16(in_row_ptr(F, m), F.norm1, orow, F.lane, xn);
        float gs[8];
#pragma unroll
        for (int g = 0; g < 8; ++g) { float s = 0.f;
#pragma unroll
            for (int j = 0; j < 4; ++j) { const f32x4 w = *(const LAS f32x4*)(wgL + g * D + 4 * F.lane + 256 * j); s += (xn[j].x * w.x + xn[j].y * w.y) + (xn[j].z * w.z + xn[j].w * w.w); }
            gs[g] = wave_sum(s); }
        float val = gs[0];
#pragma unroll
        for (int g = 1; g < 8; ++g) val = (F.lane == g) ? gs[g] : val;
        if (F.lane < 8) { val += F.b_gate[F.lane]; F.Gt[(size_t)m * 8 + F.lane] = (F.lane < 4) ? val : logsigmoidf_(val); }
    }
}

struct RecState { float C[2][4]; float n[2]; float m; };
__device__ __forceinline__ void rec_step(const Frame& F, RecState& S, int row, int h, int v0, int lane, bool write_h) {
    const bf16* q = F.P + 1 * P_STRIDE + (size_t)row * 512 + h * HD; const bf16* k = F.P + 2 * P_STRIDE + (size_t)row * 512 + h * HD; const bf16* v = F.P + 3 * P_STRIDE + (size_t)row * 512 + h * HD;
    const float ig = F.Gt[(size_t)row * 8 + h], lf = F.Gt[(size_t)row * 8 + 4 + h];
    const float q0 = bf2f(q[lane]), q1 = bf2f(q[lane + 64]), k0 = bf2f(k[lane]), k1 = bf2f(k[lane + 64]);
    const v2u vv = *(const v2u*)(v + v0); const float vj[4] = {bflo(vv.x), bfhi(vv.x), bflo(vv.y), bfhi(vv.y)};
    const float mn = fmaxf(lf + S.m, ig), a = __expf(lf + S.m - mn), bb = __expf(ig - mn); S.m = mn;
    float pn[4], pd;
    const float bk0 = bb * k0, bk1 = bb * k1;
#pragma unroll
    for (int j = 0; j < 4; ++j) { S.C[0][j] = a * S.C[0][j] + bk0 * vj[j]; S.C[1][j] = a * S.C[1][j] + bk1 * vj[j]; pn[j] = q0 * S.C[0][j] + q1 * S.C[1][j]; }
    S.n[0] = a * S.n[0] + bk0; S.n[1] = a * S.n[1] + bk1; pd = q0 * S.n[0] + q1 * S.n[1];
    if (write_h) {
#pragma unroll
        for (int j = 0; j < 4; ++j) pn[j] = wave_sum(pn[j]);
        pd = wave_sum(pd);
        const float den = fmaxf(fabsf(pd), __expf(-mn));
        if (lane == 0) { f32x4 o; o.x = pn[0] / den; o.y = pn[1] / den; o.z = pn[2] / den; o.w = pn[3] / den; *(f32x4*)(F.HRAW + (size_t)row * 512 + h * HD + v0) = o; }
    }
}
__device__ __forceinline__ void p2_mlstm_rec(Frame& F) {
    if (F.wave < 4) {
        for (int task = blockIdx.x * 4 + F.wave; task < NB * NH * 32; task += F.G * 4) {
            const int bh = task >> 5, vg = task & 31, b = bh >> 2, h = bh & 3, v0 = vg * 4;
            RecState S;
#pragma unroll
            for (int i = 0; i < 2; ++i) { S.n[i] = 0.f;
#pragma unroll
                for (int j = 0; j < 4; ++j) S.C[i][j] = 0.f; }
            S.m = 0.f;
            for (int t = 0; t < NMETA; ++t) rec_step(F, S, R_META0 + t, h, v0, F.lane, false);
            for (int t = 0; t < SEQ; ++t) rec_step(F, S, b * SEQ + t, h, v0, F.lane, true);
            float* Co = F.out + O_CP + (size_t)bh * HD * HD;
#pragma unroll
            for (int i = 0; i < 2; ++i) { f32x4 o; o.x = S.C[i][0]; o.y = S.C[i][1]; o.z = S.C[i][2]; o.w = S.C[i][3]; *(f32x4*)(Co + (size_t)(F.lane + 64 * i) * HD + v0) = o; }
            if (vg == 0) { F.out[O_NP + bh * HD + F.lane] = S.n[0]; F.out[O_NP + bh * HD + F.lane + 64] = S.n[1]; if (F.lane == 0) F.out[O_MP + bh] = S.m; }
        }
    } else {
        for (int task = blockIdx.x * 4 + (F.wave - 4); task < DECB * NH * 32; task += F.G * 4) {
            const int bh = task >> 5, vg = task & 31, b = bh >> 2, h = bh & 3, v0 = vg * 4;
            RecState S;
            const float* Ci = F.state_C + (size_t)bh * HD * HD;
#pragma unroll
            for (int i = 0; i < 2; ++i) { const f32x4 c = *(const f32x4*)(Ci + (size_t)(F.lane + 64 * i) * HD + v0); S.C[i][0] = c.x; S.C[i][1] = c.y; S.C[i][2] = c.z; S.C[i][3] = c.w; S.n[i] = F.state_n[bh * HD + F.lane + 64 * i]; }
            S.m = F.state_m[bh];
            for (int t = 0; t < DECT; ++t) rec_step(F, S, R_PROMPT + b * DECT + t, h, v0, F.lane, true);
            float* Co = F.out + O_CS + (size_t)bh * HD * HD;
#pragma unroll
            for (int i = 0; i < 2; ++i) { f32x4 o; o.x = S.C[i][0]; o.y = S.C[i][1]; o.z = S.C[i][2]; o.w = S.C[i][3]; *(f32x4*)(Co + (size_t)(F.lane + 64 * i) * HD + v0) = o; }
            if (vg == 0) { F.out[O_NS + bh * HD + F.lane] = S.n[0]; F.out[O_NS + bh * HD + F.lane + 64] = S.n[1]; if (F.lane == 0) F.out[O_MS + bh] = S.m; }
        }
    }
}

__device__ __forceinline__ float u_ext_val(const Frame& F, int row, int j, int c) {
    const bf16* U = F.P;
    if (row < R_PROMPT) { const int b = row >> 11, tr = (row & 2047) - j; const int r = tr >= 0 ? (b * SEQ + tr) : (R_META0 + NMETA + tr); return bf2f(U[(size_t)r * 512 + c]); }
    const int b = (row - R_PROMPT) >> 2, t = ((row - R_PROMPT) & 3) - j;
    if (t >= 0) return bf2f(U[(size_t)(R_PROMPT + b * DECT + t) * 512 + c]);
    return F.state_pool[((size_t)b * 15 + (15 + t)) * 512 + c];
}
__device__ __forceinline__ void p3_mix(Frame& F) {
    for (int task = F.gw; task < R_MAIN * NH; task += F.NGW) {
        const int row = task >> 2, h = task & 3;
        const f32x2 hv = *(const f32x2*)(F.HRAW + (size_t)row * 512 + h * HD + 2 * F.lane);
        const float rn = 1.f / sqrtf(wave_sum(hv.x * hv.x + hv.y * hv.y) * (1.f / HD) + EPS);
        const unsigned ow = *(const unsigned*)(F.P + 4 * P_STRIDE + (size_t)row * 512 + h * HD + 2 * F.lane);
        const f32x2 g = *(const f32x2*)(F.head_gain + h * HD + 2 * F.lane);
        *(unsigned*)(F.MIX + (size_t)row * D + PW + h * HD + 2 * F.lane) = pk2(hv.x * rn * g.x * sigmoidf_(bflo(ow)), hv.y * rn * g.y * sigmoidf_(bfhi(ow)));
    }
    LAS float* pl = (LAS float*)(F.lds + F.wave * 4096);
    for (int task = F.gw; task < (R_MAIN / 8) * 4; task += F.NGW) {
        const int tile = task >> 2, g = task & 3, w = 2 << g, row0 = tile * 8;
        const float inv = 1.f / (float)w;
        for (int t = 0; t < 8; ++t)
#pragma unroll
            for (int i = 0; i < 2; ++i) { const int c = g * 128 + F.lane + 64 * i; float s = 0.f; float u0 = 0.f;
                for (int j = 0; j < w; ++j) { const float uv = u_ext_val(F, row0 + t, j, c); s += uv; if (j == 0) u0 = uv; }
                pl[t * 128 + F.lane + 64 * i] = s * inv - u0; }
        LDS_WAIT(); asm volatile("" ::: "memory");
        float acc[8][2];
#pragma unroll
        for (int t = 0; t < 8; ++t) { acc[t][0] = 0.f; acc[t][1] = 0.f; }
        const float* wp = F.w_pool + (size_t)g * 128 * 128;
        for (int c = 0; c < 128; ++c) { const float w0 = wp[c * 128 + F.lane], w1 = wp[c * 128 + F.lane + 64];
#pragma unroll
            for (int t = 0; t < 8; ++t) { const float p = pl[t * 128 + c]; acc[t][0] += p * w0; acc[t][1] += p * w1; } }
        const float s0 = F.pool_scale[g * 128 + F.lane], s1 = F.pool_scale[g * 128 + F.lane + 64];
#pragma unroll
        for (int t = 0; t < 8; ++t) { bf16* mr = F.MIX + (size_t)(row0 + t) * D + g * 128; mr[F.lane] = (bf16)f2bf(acc[t][0] * s0); mr[F.lane + 64] = (bf16)f2bf(acc[t][1] * s1); }
        LDS_WAIT(); asm volatile("" ::: "memory");
    }
    const int gt = blockIdx.x * (NWAVES * 64) + F.tid, ngt = F.G * NWAVES * 64;
    for (int e = gt; e < NB * 15 * 512; e += ngt) { const int c = e & 511, i = (e >> 9) % 15, b = e / (15 * 512); F.out[O_POOLP + e] = bf2f(F.P[(size_t)(b * SEQ + SEQ - 15 + i) * 512 + c]); }
    for (int e = gt; e < DECB * 15 * 512; e += ngt) { const int c = e & 511, i = (e >> 9) % 15, b = e / (15 * 512);
        F.out[O_POOLS + e] = (i < 11) ? F.state_pool[((size_t)b * 15 + i + 4) * 512 + c] : bf2f(F.P[(size_t)(R_PROMPT + b * DECT + (i - 11)) * 512 + c]); }
}

__device__ __forceinline__ void p5_norm2(Frame& F) {
    for (int m = F.gw; m < R_MAIN; m += F.NGW) { f32x4 xn[4]; rms_row_to_bf16(F.out + O_Y + (size_t)m * D, F.norm2, F.XN + (size_t)m * D, F.lane, xn); }
}
__device__ __forceinline__ void p8_final(Frame& F) {
    for (int m = F.gw; m < R_MAIN; m += F.NGW) {
        GAS f32x4* xr = (GAS f32x4*)(F.out + O_Y + (size_t)m * D) + F.lane; const GAS f32x4* gr = (const GAS f32x4*)F.norm_f + F.lane;
        f32x4 v[4]; float s = 0.f;
#pragma unroll
        for (int j = 0; j < 4; ++j) { v[j] = xr[64 * j]; s += (v[j].x * v[j].x + v[j].y * v[j].y) + (v[j].z * v[j].z + v[j].w * v[j].w); }
        const float r = 1.f / sqrtf(wave_sum(s) * (1.f / D) + EPS);
#pragma unroll
        for (int j = 0; j < 4; ++j) xr[64 * j] = v[j] * r * gr[64 * j];
    }
}

struct Args { const float* in[18]; float* out; unsigned char* ws; int ph_lo, ph_hi; };
__global__ void __launch_bounds__(NWAVES * 64, 2) fwd_kernel(Args args) {
    extern __shared__ __attribute__((aligned(16))) unsigned char lds[];
    Frame F;
    F.lds = (LAS unsigned char*)lds;
    F.tid = threadIdx.x; F.lane = F.tid & 63; F.wave = __builtin_amdgcn_readfirstlane(F.tid >> 6);
    F.G = gridDim.x; F.gw = blockIdx.x * NWAVES + F.wave; F.NGW = F.G * NWAVES;
    F.x_prompt = args.in[0]; F.x_sample = args.in[1]; F.state_pool = args.in[2]; F.state_C = args.in[3]; F.state_n = args.in[4]; F.state_m = args.in[5]; F.meta = args.in[6]; F.norm1 = args.in[7];
    F.w_in = args.in[8]; F.b_gate = args.in[9]; F.w_pool = args.in[10]; F.pool_scale = args.in[11]; F.head_gain = args.in[12]; F.w_out = args.in[13]; F.norm2 = args.in[14]; F.w_up = args.in[15];
    F.w_down = args.in[16]; F.norm_f = args.in[17]; F.out = args.out;
    unsigned char* ws = args.ws;
    F.Win_t = (bf16*)(ws + WS_WIN); F.Wout_t = (bf16*)(ws + WS_WOUT); F.Wup_t = (bf16*)(ws + WS_WUP); F.Wdn_t = (bf16*)(ws + WS_WDN);
    F.Gt = (float*)(ws + WS_G); F.XN = (bf16*)(ws + WS_XN); F.P = (bf16*)(ws + WS_P); F.MIX = (bf16*)(ws + WS_MIX); F.HRAW = (float*)(ws + WS_HRAW); F.H = (bf16*)(ws + WS_H);
    for (int u = F.tid; u < (LDS_BYTES - RING_BYTES) / 4; u += NWAVES * 64) ((LAS unsigned*)(F.lds + RING_BYTES))[u] = 0u;
    __syncthreads();
    XcdBarrier bar = xcd_barrier_post((unsigned*)(ws + WS_CTL) + CW_BAR, (volatile LAS unsigned*)(F.lds + MISC_OFF) + 8);
    const int lo = args.ph_lo, hi = args.ph_hi;
#define IN(k) (lo <= (k) && (k) < hi)
#define GRID_BAR() xcd_barrier(bar)
    if (IN(0)) { p0_prologue(F); }
    if (IN(0) && IN(1)) GRID_BAR();
    if (IN(1)) { pg8::Gemm g{F.XN, F.Win_t, M_IN, NIN, D}; pg8::StaticOrder S; S.init(M_IN, NIN, F.G, (int)blockIdx.x);
        pg8::EpiIn E{F.P, P_STRIDE, 0.08838834764831845f};
        pg8::gemm_phase<pg8::EpiIn, pg8::StaticOrder, PG8_ALIGN, PG8_SP2>(F.lds, g, S, E); }
    if (IN(1) && IN(2)) GRID_BAR();
    if (IN(2)) { p2_mlstm_rec(F); }
    if (IN(2) && IN(3)) GRID_BAR();
    if (IN(3)) { p3_mix(F); }
    if (IN(3) && IN(4)) GRID_BAR();
    if (IN(4)) { pg8::Gemm g{F.MIX, F.Wout_t, R_MAIN, D, D}; pg8::StaticOrder S; S.init(R_MAIN, D, F.G, (int)blockIdx.x);
        pg8::EpiRes E{F.x_prompt, F.x_sample, R_PROMPT / 256, F.out + O_Y};
        pg8::gemm_phase<pg8::EpiRes, pg8::StaticOrder, PG8_ALIGN, PG8_SP2>(F.lds, g, S, E); }
    if (IN(4) && IN(5)) GRID_BAR();
    if (IN(5)) { p5_norm2(F); }
    if (IN(5) && IN(6)) GRID_BAR();
    if (IN(6)) { pg8::Gemm g{F.XN, F.Wup_t, R_MAIN, FF, D}; pg8::StaticOrder S; S.init(R_MAIN, FF, F.G, (int)blockIdx.x);
        pg8::EpiRelu2 E{F.H, FF};
        pg8::gemm_phase<pg8::EpiRelu2, pg8::StaticOrder, PG8_ALIGN, PG8_SP2>(F.lds, g, S, E); }
    if (IN(6) && IN(7)) GRID_BAR();
    if (IN(7)) { pg8::Gemm g{F.H, F.Wdn_t, R_MAIN, D, FF}; pg8::StaticOrder S; S.init(R_MAIN, D, F.G, (int)blockIdx.x);
        pg8::EpiRes E{F.out + O_Y, F.out + O_Y, 1 << 20, F.out + O_Y};
        pg8::gemm_phase<pg8::EpiRes, pg8::StaticOrder, PG8_ALIGN, PG8_SP2>(F.lds, g, S, E); }
    if (IN(7) && IN(8)) GRID_BAR();
    if (IN(8)) { p8_final(F); }
#undef IN
#undef GRID_BAR
}

extern "C" void kernel_launch(void* const* d_in, const int* in_sizes, int n_in, void* d_out, int out_size, void* d_ws, size_t ws_size, hipStream_t stream) {
    static int grid = 0;
    if (grid == 0) {
        if (n_in != 18 || out_size != (int)O_END || ws_size < WS_END) { fprintf(stderr, "kernel_launch: unexpected shapes n_in %d out %d ws %zu\n", n_in, out_size, ws_size); grid = -1; return; }
        int dev = 0, cus = 0;
        if (hipGetDevice(&dev) != hipSuccess || hipDeviceGetAttribute(&cus, hipDeviceAttributeMultiprocessorCount, dev) != hipSuccess) { grid = -1; return; }
        if (hipFuncSetAttribute((const void*)fwd_kernel, hipFuncAttributeMaxDynamicSharedMemorySize, LDS_BYTES) != hipSuccess) { fprintf(stderr, "kernel_launch: hipFuncSetAttribute failed\n"); grid = -1; return; }
        grid = cus;
    }
    if (grid < 0) return;
    Args a{};
    for (int i = 0; i < 18; ++i) a.in[i] = (const float*)d_in[i];
    a.out = (float*)d_out; a.ws = (unsigned char*)d_ws;
    if (hipMemsetAsync((char*)d_ws + WS_CTL, 0, CTL_ZERO_BYTES, stream) != hipSuccess) { fprintf(stderr, "kernel_launch: memset failed\n"); return; }
    a.ph_lo = 0; a.ph_hi = 9; hipLaunchKernelGGL(fwd_kernel, dim3(grid), dim3(NWAVES * 64), LDS_BYTES, stream, a);
}
```

```cpp
#include <hip/hip_runtime.h>
#include <cstdio>
#include <cstdint>
namespace pg8 {
#define PG8_LAS __attribute__((address_space(3)))
typedef unsigned short bf16_t;
typedef short bf16x8 __attribute__((ext_vector_type(8)));
typedef float f32x4 __attribute__((ext_vector_type(4)));
typedef unsigned u32x4 __attribute__((ext_vector_type(4)));
constexpr int BM = 256, BK = 64, HALF = 128, HTB = HALF * BK * 2  , STAGE_BYTES = 8 * HTB, NXCD = 8, WGM = 8;

__host__ __device__ __forceinline__ int lds_byte(int r, int c) { const int st = (r >> 4) * 2 + (c >> 5), rr = r & 15, cc = c & 31, ob = rr * 64 + cc * 2; return st * 1024 + (ob ^ (((ob >> 9) & 1) << 5)); }
__host__ __device__ __forceinline__ void stage_rc(int b, int& R, int& C) { const int st = b / 1024, sb = b % 1024, swz = sb ^ (((sb >> 9) & 1) << 5); R = (st >> 1) * 16 + swz / 64; C = (st & 1) * 32 + (swz % 64) / 2; }
__host__ __device__ __forceinline__ int perm32(int rho) { const int n = rho >> 4, i = rho & 15; return 8 * (i >> 2) + 4 * n + (i & 3); }

struct Unit { int pm, pn; };
struct Gemm { const bf16_t* A; const bf16_t* Bt; int M, N, K; };

struct StaticOrder {
    int nM, nN, nwg, G, c;
    __host__ __device__ void init(int M, int N, int G_, int c_) { nM = M / BM; nN = N / BM; nwg = nM * nN; G = G_; c = c_; }
    __host__ __device__ bool next(int i, Unit& u) const {
        const long L = (long)i * G + c; if (L >= nwg) return false;
        int wgid = (int)L; { const int q = nwg / NXCD, r = nwg % NXCD, xcd = wgid % NXCD, off = wgid / NXCD; wgid = (xcd < r ? xcd * (q + 1) : r * (q + 1) + (xcd - r) * q) + off; }
        const int nig = WGM * nN, gid = wgid / nig, fm = gid * WGM, gsz = (nM - fm) < WGM ? (nM - fm) : WGM;
        u.pm = fm + ((wgid % nig) % gsz); u.pn = (wgid % nig) / gsz; return true;
    }
    __device__ __forceinline__ void a_ready(const Unit&) const {}
    __device__ __forceinline__ void done(const Unit&) const {}
};

__device__ __forceinline__ unsigned cvt_pk_bf16(float lo, float hi) { unsigned r; asm volatile("v_cvt_pk_bf16_f32 %0, %1, %2" : "=v"(r) : "v"(lo), "v"(hi)); return r; }

struct EpiIn {
    static constexpr bool PERM = true, AFTER_DRAIN = false;
    bf16_t* O; size_t split_stride; float qscale;
    __device__ __forceinline__ void operator()(const f32x4 (&acc)[2][2][4][2], const Unit& u, int wr, int wc, int fr, int fq) const {
        const int row0 = u.pm * BM + wr * 64 + fr; const int t = u.pn >> 1; const int colt = (u.pn & 1) * BM;
        bf16_t* base = O + (size_t)t * split_stride; const float sc = (t == 1) ? qscale : 1.f;
        const int col0 = colt + wc * 32 + 8 * fq;
#pragma unroll
        for (int ai = 0; ai < 2; ++ai)
#pragma unroll
            for (int m = 0; m < 4; ++m) { bf16_t* rowp = base + (size_t)(row0 + ai * HALF + m * 16) * 512 + col0;
#pragma unroll
                for (int bj = 0; bj < 2; ++bj) { f32x4 v0 = acc[ai][bj][m][0] * sc, v1 = acc[ai][bj][m][1] * sc;
                    u32x4 w; w.x = cvt_pk_bf16(v0[0], v0[1]); w.y = cvt_pk_bf16(v0[2], v0[3]); w.z = cvt_pk_bf16(v1[0], v1[1]); w.w = cvt_pk_bf16(v1[2], v1[3]);
                    *(u32x4*)(rowp + bj * HALF) = w; } }
    }
};
struct EpiRelu2 {
    static constexpr bool PERM = true, AFTER_DRAIN = false;
    bf16_t* O; int ldc;
    __device__ __forceinline__ void operator()(const f32x4 (&acc)[2][2][4][2], const Unit& u, int wr, int wc, int fr, int fq) const {
        const int row0 = u.pm * BM + wr * 64 + fr; const int col0 = u.pn * BM + wc * 32 + 8 * fq;
#pragma unroll
        for (int ai = 0; ai < 2; ++ai)
#pragma unroll
            for (int m = 0; m < 4; ++m) { bf16_t* rowp = O + (size_t)(row0 + ai * HALF + m * 16) * ldc + col0;
#pragma unroll
                for (int bj = 0; bj < 2; ++bj) { f32x4 v0 = acc[ai][bj][m][0], v1 = acc[ai][bj][m][1];
#pragma unroll
                    for (int e = 0; e < 4; ++e) { const float a = fmaxf(v0[e], 0.f), b = fmaxf(v1[e], 0.f); v0[e] = a * a; v1[e] = b * b; }
                    u32x4 w; w.x = cvt_pk_bf16(v0[0], v0[1]); w.y = cvt_pk_bf16(v0[2], v0[3]); w.z = cvt_pk_bf16(v1[0], v1[1]); w.w = cvt_pk_bf16(v1[2], v1[3]);
                    *(u32x4*)(rowp + bj * HALF) = w; } }
    }
};
struct EpiRes {
    static constexpr bool PERM = false, AFTER_DRAIN = false;
    const float* resA; const float* resB; int split_pm; float* out;
    __device__ __forceinline__ void operator()(const f32x4 (&acc)[2][2][4][2], const Unit& u, int wr, int wc, int fr, int fq) const {
        const int row0 = u.pm * BM + wr * 64 + fr, col0 = u.pn * BM + wc * 32 + 4 * fq;
        const float* res = (u.pm < split_pm) ? resA : (resB - (size_t)split_pm * BM * 1024);
#pragma unroll
        for (int ai = 0; ai < 2; ++ai)
#pragma unroll
            for (int m = 0; m < 4; ++m) { const size_t off = (size_t)(row0 + ai * HALF + m * 16) * 1024 + col0;
#pragma unroll
                for (int bj = 0; bj < 2; ++bj)
#pragma unroll
                    for (int n = 0; n < 2; ++n) { const f32x4 r = *(const f32x4*)(res + off + bj * HALF + n * 16); *(f32x4*)(out + off + bj * HALF + n * 16) = r + acc[ai][bj][m][n]; } }
    }
};

template <class Epi, class Sched, bool ALIGN_EPI = false, bool SP2 = false>
__device__ __forceinline__ void gemm_phase(PG8_LAS unsigned char* lds, const Gemm g, const Sched& S, const Epi& E) {
    const int tid = threadIdx.x, wid = __builtin_amdgcn_readfirstlane(tid >> 6), lane = tid & 63, wr = wid >> 2, wc = wid & 3, fr = lane & 15, fq = lane >> 4;
    const int K = g.K, nt = K / BK;
    unsigned voffA[2], voffB[2];
#pragma unroll
    for (int i = 0; i < 2; ++i) { int R, C; stage_rc(tid * 16 + i * 8192, R, C); const int Rb = Epi::PERM ? ((R & ~31) + perm32(R & 31)) : R;
        voffA[i] = (unsigned)(R * K + C) * 2u; voffB[i] = (unsigned)(Rb * K + C) * 2u; }
    const size_t kstep = (size_t)(BK * 2);
    const size_t hstep = (size_t)HALF * K * 2;
    const size_t tstep = 2 * hstep;
    const unsigned ldsw = (unsigned)wid * 1024u;
    const int aoff = lds_byte(wr * 64 + fr, fq * 8), boff = lds_byte(wc * 32 + fr, fq * 8);
#define PG8_SA(b, h) (((b) * 2 + (h)) * HTB)
#define PG8_SB(b, h) ((4 + (b) * 2 + (h)) * HTB)
#define PG8_STAGE(bufoff, gbase, voff) do { _Pragma("unroll") for (int _i = 0; _i < 2; ++_i) \
        __builtin_amdgcn_global_load_lds((const unsigned*)((const char*)(gbase) + (voff)[_i]), (PG8_LAS unsigned*)(lds + (bufoff) + ldsw + _i * 8192), 16, 0, 0); } while (0)
#define PG8_LDA(dst, b, h) do { _Pragma("unroll") for (int m = 0; m < 4; ++m) _Pragma("unroll") for (int k = 0; k < 2; ++k) dst[m][k] = *(const PG8_LAS bf16x8*)(lds + PG8_SA(b, h) + aoff + m * 2048 + k * 1024); } while (0)
#define PG8_LDB(dst, b, h) do { _Pragma("unroll") for (int n = 0; n < 2; ++n) _Pragma("unroll") for (int k = 0; k < 2; ++k) dst[n][k] = *(const PG8_LAS bf16x8*)(lds + PG8_SB(b, h) + boff + n * 2048 + k * 1024); } while (0)
#define PG8_MMA(ai, bj, At, Bt) do { __builtin_amdgcn_s_setprio(1); _Pragma("unroll") for (int m = 0; m < 4; ++m) _Pragma("unroll") for (int n = 0; n < 2; ++n) _Pragma("unroll") for (int k = 0; k < 2; ++k) \
        acc[ai][bj][m][n] = __builtin_amdgcn_mfma_f32_16x16x32_bf16(Bt[n][k], At[m][k], acc[ai][bj][m][n], 0, 0, 0); __builtin_amdgcn_s_setprio(0); } while (0)
#define PG8_WAIT_V(n) asm volatile("s_waitcnt vmcnt(" #n ")" ::: "memory")
#define PG8_WAIT_L(n) asm volatile("s_waitcnt lgkmcnt(" #n ")" ::: "memory")
#define PG8_BAR __builtin_amdgcn_s_barrier()
#define PG8_SCHED __builtin_amdgcn_sched_barrier(0)
    Unit cur, nxt; int ui = 0;
    if (!S.next(0, cur)) return;
    f32x4 acc[2][2][4][2];
#pragma unroll
    for (int a = 0; a < 2; ++a)
#pragma unroll
        for (int b = 0; b < 2; ++b)
#pragma unroll
            for (int m = 0; m < 4; ++m)
#pragma unroll
                for (int n = 0; n < 2; ++n) acc[a][b][m][n] = (f32x4){0.f, 0.f, 0.f, 0.f};
    bf16x8 At[4][2], B0[2][2], B1[2][2];
    const char* cA = (const char*)g.A + (size_t)cur.pm * tstep; const char* cB = (const char*)g.Bt + (size_t)cur.pn * tstep;
    S.a_ready(cur);
    if constexpr (SP2) {
        PG8_STAGE(PG8_SB(0, 0), cB, voffB); PG8_STAGE(PG8_SB(0, 1), cB + hstep, voffB); PG8_STAGE(PG8_SA(0, 0), cA, voffA); PG8_STAGE(PG8_SA(0, 1), cA + hstep, voffA);
        if (wr == 1) PG8_BAR;
        PG8_WAIT_V(2); PG8_BAR;
        PG8_STAGE(PG8_SB(1, 0), cB + kstep, voffB); PG8_STAGE(PG8_SA(1, 0), cA + kstep, voffA); PG8_STAGE(PG8_SB(1, 1), cB + hstep + kstep, voffB);
        PG8_WAIT_V(6); PG8_BAR;
    } else {
        PG8_STAGE(PG8_SB(0, 0), cB, voffB); PG8_STAGE(PG8_SA(0, 0), cA, voffA); PG8_STAGE(PG8_SB(0, 1), cB + hstep, voffB); PG8_STAGE(PG8_SA(0, 1), cA + hstep, voffA);
        if (wr == 1) PG8_BAR;
        PG8_WAIT_V(4); PG8_BAR;
        PG8_STAGE(PG8_SB(1, 0), cB + kstep, voffB); PG8_STAGE(PG8_SA(1, 0), cA + kstep, voffA); PG8_STAGE(PG8_SB(1, 1), cB + hstep + kstep, voffB);
        PG8_WAIT_V(6); PG8_BAR;
    }
    for (;;) {
        const bool has_next = S.next(ui + 1, nxt);
        const char* nA = has_next ? (const char*)g.A + (size_t)nxt.pm * tstep : cA; const char* nB = has_next ? (const char*)g.Bt + (size_t)nxt.pn * tstep : cB;
        for (int t = 0; t < nt; t += 2) {
            const bool last = (t == nt - 2);
            const char* a1 = cA + (size_t)(t + 1) * kstep;
            const char* a2 = last ? nA : cA + (size_t)(t + 2) * kstep; const char* b2 = last ? nB : cB + (size_t)(t + 2) * kstep;
            const char* a3 = a2 + kstep; const char* b3 = b2 + kstep;
            if (last && has_next) S.a_ready(nxt);
            if constexpr (SP2) {
            PG8_LDB(B0, 0, 0); PG8_LDB(B1, 0, 1); PG8_SCHED; PG8_LDA(At, 0, 0); PG8_STAGE(PG8_SA(1, 1), a1 + hstep, voffA);
            PG8_WAIT_V(8); PG8_WAIT_L(0); PG8_BAR; PG8_MMA(0, 0, At, B0); PG8_MMA(0, 1, At, B1); PG8_BAR; PG8_SCHED;
            PG8_LDA(At, 0, 1); PG8_STAGE(PG8_SB(0, 0), b2, voffB); PG8_STAGE(PG8_SB(0, 1), b2 + hstep, voffB); PG8_STAGE(PG8_SA(0, 0), a2, voffA);
            PG8_WAIT_V(8); PG8_WAIT_L(0); PG8_BAR; PG8_MMA(1, 0, At, B0); PG8_MMA(1, 1, At, B1); PG8_BAR; PG8_SCHED;
            PG8_LDB(B0, 1, 0); PG8_LDB(B1, 1, 1); PG8_SCHED; PG8_LDA(At, 1, 0); PG8_STAGE(PG8_SA(0, 1), a2 + hstep, voffA);
            PG8_WAIT_V(8); PG8_WAIT_L(0); PG8_BAR; PG8_MMA(0, 0, At, B0); PG8_MMA(0, 1, At, B1); PG8_BAR; PG8_SCHED;
            PG8_LDA(At, 1, 1); PG8_STAGE(PG8_SB(1, 0), b3, voffB); PG8_STAGE(PG8_SB(1, 1), b3 + hstep, voffB); PG8_STAGE(PG8_SA(1, 0), a3, voffA);
            PG8_WAIT_V(8); PG8_WAIT_L(0); PG8_BAR; PG8_MMA(1, 0, At, B0); PG8_MMA(1, 1, At, B1); PG8_BAR; PG8_SCHED;
            } else {
            PG8_LDB(B0, 0, 0); PG8_SCHED; PG8_LDA(At, 0, 0); PG8_STAGE(PG8_SA(1, 1), a1 + hstep, voffA);
            PG8_WAIT_L(8); PG8_BAR; PG8_WAIT_L(0); PG8_MMA(0, 0, At, B0); PG8_BAR; PG8_SCHED;
            PG8_LDB(B1, 0, 1); PG8_STAGE(PG8_SB(0, 0), b2, voffB);
            PG8_BAR; PG8_WAIT_L(0); PG8_MMA(0, 1, At, B1); PG8_BAR;
            PG8_LDA(At, 0, 1); PG8_STAGE(PG8_SA(0, 0), a2, voffA);
            PG8_BAR; PG8_WAIT_L(0); PG8_MMA(1, 0, At, B0); PG8_BAR; PG8_SCHED;
            PG8_STAGE(PG8_SB(0, 1), b2 + hstep, voffB);
            PG8_WAIT_V(6); PG8_BAR; PG8_MMA(1, 1, At, B1); PG8_BAR;
            PG8_LDB(B0, 1, 0); PG8_SCHED; PG8_LDA(At, 1, 0); PG8_STAGE(PG8_SA(0, 1), a2 + hstep, voffA);
            PG8_WAIT_L(8); PG8_BAR; PG8_WAIT_L(0); PG8_MMA(0, 0, At, B0); PG8_BAR; PG8_SCHED;
            PG8_LDB(B1, 1, 1); PG8_STAGE(PG8_SB(1, 0), b3, voffB);
            PG8_BAR; PG8_WAIT_L(0); PG8_MMA(0, 1, At, B1); PG8_BAR;
            PG8_LDA(At, 1, 1); PG8_STAGE(PG8_SA(1, 0), a3, voffA);
            PG8_BAR; PG8_WAIT_L(0); PG8_MMA(1, 0, At, B0); PG8_BAR; PG8_SCHED;
            PG8_STAGE(PG8_SB(1, 1), b3 + hstep, voffB);
            PG8_WAIT_V(6); PG8_BAR; PG8_MMA(1, 1, At, B1); PG8_BAR;
            }
        }
        if constexpr (ALIGN_EPI) { if (wr == 0) PG8_BAR; }
        if constexpr (!Epi::AFTER_DRAIN) { E(acc, cur, wr, wc, fr, fq); S.done(cur); }
        if (!has_next) break;
#pragma unroll
        for (int a = 0; a < 2; ++a)
#pragma unroll
            for (int b = 0; b < 2; ++b)
#pragma unroll
                for (int m = 0; m < 4; ++m)
#pragma unroll
                    for (int n = 0; n < 2; ++n) acc[a][b][m][n] = (f32x4){0.f, 0.f, 0.f, 0.f};
        cur = nxt; cA = nA; cB = nB; ++ui;
        if constexpr (ALIGN_EPI) { if (wr == 1) PG8_BAR; }
    }
    PG8_WAIT_V(0);
    if constexpr (!ALIGN_EPI) { if (wr == 0) PG8_BAR; }
    PG8_BAR;
    if constexpr (Epi::AFTER_DRAIN) { E.fused(acc, cur, wr, wc, fr, fq, lds, wid, lane); S.done(cur); }
#undef PG8_SA
#undef PG8_SB
#undef PG8_STAGE
#undef PG8_LDA
#undef PG8_LDB
#undef PG8_MMA
#undef PG8_WAIT_V
#undef PG8_WAIT_L
#undef PG8_BAR
#undef PG8_SCHED
}
}
#ifndef PG8_SP2
#define PG8_SP2 true
#endif
#ifndef PG8_ALIGN
#define PG8_ALIGN true
#endif
constexpr int NWAVES = 8;
constexpr int D = 1024, NB = 8, SEQ = 2048, DECB = 128, DECT = 4, NMETA = 16;
constexpr int PW = 512, NH = 4, HD = 128, FF = 4096, INC = 2568, NIN = 2560;
constexpr int R_PROMPT = NB * SEQ;
constexpr int R_SAMPLE = DECB * DECT;
constexpr int R_MAIN = R_PROMPT + R_SAMPLE;
constexpr int R_META0 = R_MAIN;
constexpr int R_IN = R_MAIN + NMETA;
constexpr int M_IN = 17152;
constexpr int LP = SEQ + NMETA;
constexpr float EPS = 1e-6f;
constexpr size_t MiB = 1u << 20;
constexpr size_t WS_CTL = 0, CTL_ZERO_BYTES = 1 * MiB;
constexpr int CW_BAR = 4096;
constexpr size_t WS_WIN = 1 * MiB, WS_WOUT = 6 * MiB, WS_WUP = 8 * MiB, WS_WDN = 16 * MiB;
constexpr size_t WS_G = 24 * MiB;
constexpr size_t WS_WPT = 24 * MiB + 640 * 1024;
constexpr size_t WS_XN = 25 * MiB;
constexpr size_t WS_P = 59 * MiB;
constexpr size_t P_STRIDE = (size_t)M_IN * 512;
constexpr size_t WS_MIX = 143 * MiB;
constexpr size_t WS_CST = 176 * MiB;
constexpr size_t WS_NST = 208 * MiB;
constexpr size_t WS_SCB = 208 * MiB + 512 * 1024;
constexpr size_t WS_SCM = WS_SCB + 288 * 1024;
constexpr size_t WS_M0 = WS_SCM + 288 * 1024;
constexpr size_t WS_H = 59 * MiB;
constexpr size_t WS_END = 210 * MiB;
static_assert(WS_P + 5 * P_STRIDE * 2 <= WS_MIX && WS_MIX + (size_t)R_MAIN * 1024 * 2 <= WS_CST && WS_M0 + 32 * 34 * 4 <= WS_END && WS_H + (size_t)R_MAIN * FF * 2 <= WS_END, "d_ws map");
constexpr size_t O_Y = 0, O_POOLP = 17301504, O_CP = 17362944, O_NP = 17887232, O_MP = 17891328, O_POOLS = 17891360, O_CS = 18874400, O_NS = 27263008, O_MS = 27328544, O_END = 27329056;
constexpr int RING_BYTES = 131072, LDS_BYTES = 147456, MISC_OFF = RING_BYTES + 320;

#define GAS __attribute__((address_space(1)))
#define LAS __attribute__((address_space(3)))
typedef unsigned short bf16;
typedef unsigned v4u __attribute__((ext_vector_type(4)));
typedef unsigned v2u __attribute__((ext_vector_type(2)));
typedef float f32x4 __attribute__((ext_vector_type(4)));
typedef float f32x2 __attribute__((ext_vector_type(2)));
#define LDS_WAIT() asm volatile("s_waitcnt lgkmcnt(0)" ::: "memory")
#define VM_WAIT() asm volatile("s_waitcnt vmcnt(0)" ::: "memory")
__device__ __forceinline__ unsigned f2bf(float f) { unsigned u = __builtin_bit_cast(unsigned, f); return (u + 0x7fffu + ((u >> 16) & 1u)) >> 16; }
__device__ __forceinline__ unsigned pk2(float lo, float hi) { return f2bf(lo) | (f2bf(hi) << 16); }
__device__ __forceinline__ float bf2f(unsigned short b) { return __builtin_bit_cast(float, (unsigned)b << 16); }
__device__ __forceinline__ float bflo(unsigned w) { return __builtin_bit_cast(float, w << 16); }
__device__ __forceinline__ float bfhi(unsigned w) { return __builtin_bit_cast(float, w & 0xffff0000u); }
__device__ __forceinline__ float wave_sum(float v) {
#pragma unroll
    for (int o = 1; o < 64; o <<= 1) v += __shfl_xor(v, o);
    return v;
}
__device__ __forceinline__ float sigmoidf_(float x) { return 1.f / (1.f + __expf(-x)); }
__device__ __forceinline__ float logsigmoidf_(float x) { return fminf(x, 0.f) - log1pf(expf(-fabsf(x))); }

#define XB_TMO      128
#define XB_XCNT(j)  (256  + 64 * (j))
#define XB_XSUB(j)  (1280 + 64 * (j))
#define XB_XGEN(j)  (2304 + 64 * (j))
#define XB_TOP      3328
#define XB_TOPGEN   3392
#define XCD_BAR_WORDS 3456
#define XB_SPIN_CAP (1u << 18)

__device__ __forceinline__ unsigned xb_ld(unsigned* p)              { return __hip_atomic_load(p, __ATOMIC_RELAXED, __HIP_MEMORY_SCOPE_AGENT); }
__device__ __forceinline__ unsigned xb_add(unsigned* p, unsigned v) { return __hip_atomic_fetch_add(p, v, __ATOMIC_RELAXED, __HIP_MEMORY_SCOPE_AGENT); }
__device__ __forceinline__ unsigned xb_xcc_id() { return (unsigned)__builtin_amdgcn_s_getreg((3 << 11) | 20) & 0xFu; }
#define XB_SPIN(cond, bar) do { unsigned _sp = 0; while (cond) { __builtin_amdgcn_s_sleep(1); \
    if ((++_sp & 255u) == 0u) { if (xb_ld(&(bar)[XB_TMO])) break; if (_sp > XB_SPIN_CAP) { atomicAdd(&(bar)[XB_TMO], 1u); break; } } } } while (0)

struct XcdBarrier {
    unsigned* bar; unsigned x;
    volatile LAS unsigned* st;
};

__device__ __forceinline__ XcdBarrier xcd_barrier_post(unsigned* bar, volatile LAS unsigned* st) {
    XcdBarrier b; b.bar = bar; b.x = xb_xcc_id(); b.st = st;
    if (threadIdx.x == 0) (void)xb_add(&bar[XB_XCNT(b.x)], 1u);
    return b;
}
__device__ __forceinline__ void xcd_barrier_complete(unsigned* bar, unsigned x, unsigned& nloc, unsigned& nx) {
    const unsigned G = gridDim.x * gridDim.y * gridDim.z;
    unsigned sum, cnt, mine, sp = 0u;
    for (;;) {
        sum = 0u; cnt = 0u; mine = 0u;
#pragma unroll
        for (unsigned j = 0; j < 16; ++j) { const unsigned c = xb_ld(&bar[XB_XCNT(j)]); sum += c; cnt += (c > 0u) ? 1u : 0u; mine = (j == x) ? c : mine; }
        if (sum == G) break;
        __builtin_amdgcn_s_sleep(1);
        if ((++sp & 255u) == 0u) { if (xb_ld(&bar[XB_TMO])) break; if (sp > XB_SPIN_CAP) { atomicAdd(&bar[XB_TMO], 1u); break; } }
    }
    nloc = mine > 0u ? mine : 1u; nx = cnt > 0u ? cnt : 1u;
}

__device__ __forceinline__ void xcd_barrier(const XcdBarrier& b) {
    asm volatile("s_waitcnt vmcnt(0)" ::: "memory");
    __syncthreads();
    if (threadIdx.x == 0) {
        unsigned* bar = b.bar;
        __builtin_amdgcn_s_waitcnt(0);
        unsigned nloc = b.st[0], nx = b.st[1];
        if (nloc == 0u) { xcd_barrier_complete(bar, b.x, nloc, nx); b.st[0] = nloc; b.st[1] = nx; }
        const unsigned old = xb_add(&bar[XB_XSUB(b.x)], 1u);
        const unsigned gen = old / nloc;
        if (old + 1u == (gen + 1u) * nloc) {
            __builtin_amdgcn_fence(__ATOMIC_RELEASE, "agent");
            asm volatile("s_waitcnt vmcnt(0)" ::: "memory");
            const unsigned og = xb_add(&bar[XB_TOP], 1u);
            const unsigned tg = og / nx;
            if (og + 1u == (tg + 1u) * nx) xb_add(&bar[XB_TOPGEN], 1u);
            else XB_SPIN(xb_ld(&bar[XB_TOPGEN]) == tg, bar);
            __builtin_amdgcn_fence(__ATOMIC_ACQUIRE, "agent");
            xb_add(&bar[XB_XGEN(b.x)], 1u);
            asm volatile("s_waitcnt vmcnt(0)" ::: "memory");
        } else {
            XB_SPIN(xb_ld(&bar[XB_XGEN(b.x)]) == gen, bar);
            __builtin_amdgcn_fence(__ATOMIC_ACQUIRE, "agent");
            asm volatile("s_waitcnt vmcnt(0)" ::: "memory");
        }
    }
    __syncthreads();
}

struct Frame {
    LAS unsigned char* lds;
    int tid, lane, wave, G, gw, NGW;
    const float *x_prompt, *x_sample, *state_pool, *state_C, *state_n, *state_m, *meta, *norm1, *w_in, *b_gate, *w_pool, *pool_scale, *head_gain, *w_out, *norm2, *w_up, *w_down, *norm_f;
    float* out;
    bf16 *Win_t, *Wout_t, *Wup_t, *Wdn_t, *XN, *P, *MIX, *H;
    float *Gt, *NST, *SCB, *SCM, *M0;
    bf16 *CST, *WpT;
};

__device__ __forceinline__ void p0_transpose_item(const float* W, int K, int ldw, int ncols, bf16* WT, LAS float* scr, int item, int lane) {
    const int nblk = ncols / 32, kb = item / nblk, nb = item % nblk, k0 = 64 * kb, n0 = 32 * nb;
#pragma unroll 8
    for (int i = 0; i < 32; ++i) { const int kk = 2 * i + (lane >> 5); scr[kk * 33 + (lane & 31)] = W[(size_t)(k0 + kk) * ldw + n0 + (lane & 31)]; }
    LDS_WAIT(); asm volatile("" ::: "memory");
    const int c = lane & 7;
#pragma unroll
    for (int j = 0; j < 4; ++j) { const int n = (lane >> 3) + 8 * j; const LAS float* s = scr + (8 * c) * 33 + n;
        v4u o; o.x = pk2(s[0 * 33], s[1 * 33]); o.y = pk2(s[2 * 33], s[3 * 33]); o.z = pk2(s[4 * 33], s[5 * 33]); o.w = pk2(s[6 * 33], s[7 * 33]);
        *(GAS v4u*)(WT + (size_t)(n0 + n) * K + k0 + 8 * c) = o; }
    LDS_WAIT(); asm volatile("" ::: "memory");
}
__device__ __forceinline__ const float* in_row_ptr(const Frame& F, int r) {
    return r < R_PROMPT ? F.x_prompt + (size_t)r * D : (r < R_MAIN ? F.x_sample + (size_t)(r - R_PROMPT) * D : F.meta + (size_t)(r - R_META0) * D);
}
__device__ __forceinline__ void rms_row_to_bf16(const float* xrow, const float* g, bf16* orow, int lane, f32x4 (&xn)[4]) {
    const GAS f32x4* xr = (const GAS f32x4*)xrow + lane; const GAS f32x4* gr = (const GAS f32x4*)g + lane;
    float s = 0.f;
#pragma unroll
    for (int j = 0; j < 4; ++j) { xn[j] = xr[64 * j]; s += (xn[j].x * xn[j].x + xn[j].y * xn[j].y) + (xn[j].z * xn[j].z + xn[j].w * xn[j].w); }
    const float r = 1.f / sqrtf(wave_sum(s) * (1.f / D) + EPS);
    GAS v2u* o8 = (GAS v2u*)orow + lane;
#pragma unroll
    for (int j = 0; j < 4; ++j) { xn[j] = xn[j] * r * gr[64 * j]; v2u w; w.x = pk2(xn[j].x, xn[j].y); w.y = pk2(xn[j].z, xn[j].w); o8[64 * j] = w; }
}
__device__ __forceinline__ void p0_prologue(Frame& F) {
    LAS float* scr = (LAS float*)(F.lds + F.wave * 8448);
    LAS float* wgL = (LAS float*)(F.lds + 69632);
    for (int e = F.tid; e < 8 * D; e += NWAVES * 64) { const int g = e >> 10, k = e & 1023; wgL[e] = F.w_in[(size_t)k * INC + NIN + g]; }
    constexpr int I_IN = (D / 64) * (NIN / 32), I_OUT = (D / 64) * (D / 32), I_UP = (D / 64) * (FF / 32), I_DN = (FF / 64) * (D / 32);
    constexpr int NITEMS = I_IN + I_OUT + I_UP + I_DN;
    for (int it = F.gw; it < NITEMS; it += F.NGW) {
        int r = it;
        if (r < I_IN) { p0_transpose_item(F.w_in, D, INC, NIN, F.Win_t, scr, r, F.lane); continue; } r -= I_IN;
        if (r < I_OUT) { p0_transpose_item(F.w_out, D, D, D, F.Wout_t, scr, r, F.lane); continue; } r -= I_OUT;
        if (r < I_UP) { p0_transpose_item(F.w_up, D, FF, FF, F.Wup_t, scr, r, F.lane); continue; } r -= I_UP;
        p0_transpose_item(F.w_down, FF, D, D, F.Wdn_t, scr, r, F.lane);
    }
    for (int e = blockIdx.x * (NWAVES * 64) + F.tid; e < 4 * 128 * 128; e += F.G * NWAVES * 64) { const int g = e >> 14, d = (e >> 7) & 127, c = e & 127; F.WpT[e] = (bf16)f2bf(F.w_pool[(size_t)g * 16384 + c * 128 + d]); }
    __syncthreads();
    for (int m = F.gw; m < M_IN; m += F.NGW) {
        bf16* orow = F.XN + (size_t)m * D;
        if (m >= R_IN) { GAS v2u* o8 = (GAS v2u*)orow + F.lane; v2u z; z.x = 0u; z.y = 0u;
#pragma unroll
            for (int j = 0; j < 4; ++j) o8[64 * j] = z;
            if (F.lane < 8) F.Gt[(size_t)m * 8 + F.lane] = 0.f;
            continue; }
        f32x4 xn[4];
        rms_row_to_bf16(in_row_ptr(F, m), F.norm1, orow, F.lane, xn);
        float gs[8];
#pragma unroll
        for (int g = 0; g < 8; ++g) { float s = 0.f;
#pragma unroll
            for (int j = 0; j < 4; ++j) { const f32x4 w = *(const LAS f32x4*)(wgL + g * D + 4 * F.lane + 256 * j); s += (xn[j].x * w.x + xn[j].y * w.y) + (xn[j].z * w.z + xn[j].w * w.w); }
            gs[g] = wave_sum(s); }
        float val = gs[0];
#pragma unroll
        for (int g = 1; g < 8; ++g) val = (F.lane == g) ? gs[g] : val;
        if (F.lane < 8) { val += F.b_gate[F.lane]; F.Gt[(size_t)m * 8 + F.lane] = (F.lane < 4) ? val : logsigmoidf_(val); }
    }
}

typedef short bf16x8 __attribute__((ext_vector_type(8)));
typedef short s16x4 __attribute__((ext_vector_type(4)));
typedef float f32x16 __attribute__((ext_vector_type(16)));
#define MFMA32(a, b, c) __builtin_amdgcn_mfma_f32_32x32x16_bf16((a), (b), (c), 0, 0, 0)
__device__ __forceinline__ s16x4 vtr(const LAS unsigned char* p) { return __builtin_bit_cast(s16x4, __builtin_amdgcn_ds_read_tr16_b64_v4i16((LAS s16x4*)p)); }
__device__ __forceinline__ bf16x8 cat8(s16x4 lo, s16x4 hi) { return __builtin_shufflevector(lo, hi, 0, 1, 2, 3, 4, 5, 6, 7); }
__device__ __forceinline__ unsigned cvtpk(float lo, float hi) { typedef __bf16 bf16x2_t __attribute__((ext_vector_type(2))); f32x2 v = {lo, hi}; bf16x2_t b = __builtin_convertvector(v, bf16x2_t); return __builtin_bit_cast(unsigned, b); }
constexpr int IMG_STRIDE = 320;
constexpr int IMG_BYTES = 64 * IMG_STRIDE;
__device__ __forceinline__ int chunk_T(int c) { return c ? 64 : 16; }
__device__ __forceinline__ int chunk_p0(int c) { return c ? NMETA + (c - 1) * 64 : 0; }
__device__ __forceinline__ int chunk_row0(int b, int c) { return c ? b * SEQ + (c - 1) * 64 : R_META0; }

__device__ __forceinline__ void s_chain(Frame& F, int bh) {
    const int b = bh >> 2, h = bh & 3, tid = F.tid, lane = F.lane, wave = F.wave;
    LAS float* sb = (LAS float*)(F.lds + 4 * IMG_BYTES); LAS float* sg = sb + 2080; LAS float* sig = sg + 2080; LAS float* sB = sig + 2080; LAS float* sMl = sB + 40; LAS float* sm0 = sMl + 40;
    const bf16* Kp = F.P + 2 * P_STRIDE + h * HD; const bf16* Vp = F.P + 3 * P_STRIDE + h * HD;
    for (int c = wave; c < 33; c += NWAVES) {
        const int T = chunk_T(c), p0 = chunk_p0(c), row0 = chunk_row0(b, c);
        float lf = 0.f, ig = -INFINITY;
        if (lane < T) { lf = F.Gt[(size_t)(row0 + lane) * 8 + 4 + h]; ig = F.Gt[(size_t)(row0 + lane) * 8 + h]; }
        float bs = lf;
#pragma unroll
        for (int o = 1; o < 64; o <<= 1) { const float t = __shfl_up(bs, o); if (lane >= o) bs += t; }
        float g = ig - bs;
#pragma unroll
        for (int o = 1; o < 64; o <<= 1) { const float t = __shfl_up(g, o); if (lane >= o) g = fmaxf(g, t); }
        if (lane < T) { sb[p0 + lane] = bs; sg[p0 + lane] = g; sig[p0 + lane] = ig; }
        const float Bc = __shfl(bs, T - 1), gl = __shfl(g, T - 1);
        if (lane == 0) { sB[c] = Bc; sMl[c] = Bc + gl; }
    }
    __syncthreads();
    if (tid == 0) { float m = 0.f; sm0[0] = 0.f; for (int c = 0; c < 33; ++c) { m = fmaxf(m + sB[c], sMl[c]); sm0[c + 1] = m; } }
    __syncthreads();
    for (int p = tid; p < LP; p += NWAVES * 64) { const int c = p < NMETA ? 0 : ((p - NMETA) >> 6) + 1; F.SCB[(size_t)bh * LP + p] = sb[p]; F.SCM[(size_t)bh * LP + p] = sb[p] + fmaxf(sm0[c], sg[p]); }
    if (tid < 34) F.M0[bh * 34 + tid] = sm0[tid];
    const int ki = wave >> 1, vj0 = 2 * (wave & 1); const bool nwave = (wave & 1) == 0;
    const int i16 = lane & 15, q4 = i16 >> 2, p4 = i16 & 3, blk = (lane >> 4) & 1, hh = lane >> 5, r32 = lane & 31;
    f32x16 acc0, acc1, accn;
#pragma unroll
    for (int i = 0; i < 16; ++i) { acc0[i] = 0.f; acc1[i] = 0.f; accn[i] = 0.f; }
    bf16x8 ones;
#pragma unroll
    for (int j = 0; j < 8; ++j) ones[j] = (r32 == 0) ? (short)0x3F80 : (short)0;
    v4u st[4];
#define S_LOAD(c_) do { const int T_ = chunk_T(c_), row0_ = chunk_row0(b, c_); _Pragma("unroll") for (int i = 0; i < 4; ++i) { const int id = (tid + 512 * i) & 1023, row = id >> 4, cc = id & 15; \
        st[i] = (v4u){0u, 0u, 0u, 0u}; if (row < T_) st[i] = *(const v4u*)((i < 2 ? Kp : Vp) + (size_t)(row0_ + row) * 512 + cc * 8); } } while (0)
#define S_WRITE(c_, d_) do { const int T_ = chunk_T(c_), p0_ = chunk_p0(c_); const float Bc_ = sB[c_], ml_ = sm0[(c_) + 1]; _Pragma("unroll") for (int i = 0; i < 4; ++i) { const int id = (tid + 512 * i) & 1023, row = id >> 4, cc = id & 15; \
        v4u w = st[i]; if (i < 2) { const float ws = (row < T_) ? __expf(Bc_ - sb[p0_ + row] + sig[p0_ + row] - ml_) : 0.f; \
            w.x = cvtpk(bflo(w.x) * ws, bfhi(w.x) * ws); w.y = cvtpk(bflo(w.y) * ws, bfhi(w.y) * ws); w.z = cvtpk(bflo(w.z) * ws, bfhi(w.z) * ws); w.w = cvtpk(bflo(w.w) * ws, bfhi(w.w) * ws); } \
        *(LAS v4u*)(F.lds + (d_) * 2 * IMG_BYTES + (i < 2 ? 0 : IMG_BYTES) + row * IMG_STRIDE + cc * 16) = w; } } while (0)
    S_LOAD(0); S_WRITE(0, 0);
    __syncthreads();
    for (int c = 0; c < 33; ++c) {
        const int d = c & 1;
        if (c + 1 < 33) S_LOAD(c + 1);
        const float dec = __expf(sB[c] + sm0[c] - sm0[c + 1]);
        if (c >= 1) {
            bf16* Cs = F.CST + ((size_t)(bh * 32 + (c - 1)) * HD) * HD;
#pragma unroll
            for (int g = 0; g < 4; ++g) {
                v2u w0; w0.x = cvtpk(acc0[4 * g], acc0[4 * g + 1]); w0.y = cvtpk(acc0[4 * g + 2], acc0[4 * g + 3]);
                v2u w1; w1.x = cvtpk(acc1[4 * g], acc1[4 * g + 1]); w1.y = cvtpk(acc1[4 * g + 2], acc1[4 * g + 3]);
                *(v2u*)(Cs + (size_t)(32 * vj0 + r32) * HD + 32 * ki + 8 * g + 4 * hh) = w0;
                *(v2u*)(Cs + (size_t)(32 * (vj0 + 1) + r32) * HD + 32 * ki + 8 * g + 4 * hh) = w1;
            }
            if (nwave && r32 == 0) { float* Ns = F.NST + (size_t)(bh * 32 + (c - 1)) * HD + 32 * ki + 4 * hh;
#pragma unroll
                for (int g = 0; g < 4; ++g) { f32x4 o; o.x = accn[4 * g]; o.y = accn[4 * g + 1]; o.z = accn[4 * g + 2]; o.w = accn[4 * g + 3]; *(f32x4*)(Ns + 8 * g) = o; } }
        }
#pragma unroll
        for (int i = 0; i < 16; ++i) { acc0[i] *= dec; acc1[i] *= dec; accn[i] *= dec; }
        const LAS unsigned char* kb = F.lds + d * 2 * IMG_BYTES; const LAS unsigned char* vb = kb + IMG_BYTES;
        const int nsteps = c ? 4 : 1;
        for (int s = 0; s < nsteps; ++s) {
            const int rlo = 16 * s + 8 * hh + q4;
            const bf16x8 A = cat8(vtr(kb + rlo * IMG_STRIDE + 2 * (32 * ki + 16 * blk + 4 * p4)), vtr(kb + (rlo + 4) * IMG_STRIDE + 2 * (32 * ki + 16 * blk + 4 * p4)));
            const bf16x8 B0 = cat8(vtr(vb + rlo * IMG_STRIDE + 2 * (32 * vj0 + 16 * blk + 4 * p4)), vtr(vb + (rlo + 4) * IMG_STRIDE + 2 * (32 * vj0 + 16 * blk + 4 * p4)));
            const bf16x8 B1 = cat8(vtr(vb + rlo * IMG_STRIDE + 2 * (32 * (vj0 + 1) + 16 * blk + 4 * p4)), vtr(vb + (rlo + 4) * IMG_STRIDE + 2 * (32 * (vj0 + 1) + 16 * blk + 4 * p4)));
            acc0 = MFMA32(A, B0, acc0); acc1 = MFMA32(A, B1, acc1);
            if (nwave) accn = MFMA32(A, ones, accn);
        }
        if (c + 1 < 33) S_WRITE(c + 1, d ^ 1);
        __syncthreads();
    }
#undef S_LOAD
#undef S_WRITE
    float* Co = F.out + O_CP + (size_t)bh * HD * HD;
#pragma unroll
    for (int i = 0; i < 16; ++i) { const int kk = 32 * ki + (i & 3) + 8 * (i >> 2) + 4 * hh; Co[(size_t)kk * HD + 32 * vj0 + r32] = acc0[i]; Co[(size_t)kk * HD + 32 * (vj0 + 1) + r32] = acc1[i]; }
    if (nwave && r32 == 0) {
#pragma unroll
        for (int i = 0; i < 16; ++i) F.out[O_NP + bh * HD + 32 * ki + (i & 3) + 8 * (i >> 2) + 4 * hh] = accn[i]; }
    if (tid == 0) F.out[O_MP + bh] = sm0[33];
}

__device__ __forceinline__ void s_sample_task(Frame& F, int task) {
    const int bs = task >> 2, h = task & 3, rowb = R_PROMPT + bs * DECT, lane = F.lane, wave = F.wave;
    LAS float* red = (LAS float*)F.lds;
    float lf[4], ig[4], bt[4], mt[4];
    const float m0 = F.state_m[task];
    { float mp = m0, ba = 0.f;
#pragma unroll
      for (int t = 0; t < 4; ++t) { lf[t] = F.Gt[(size_t)(rowb + t) * 8 + 4 + h]; ig[t] = F.Gt[(size_t)(rowb + t) * 8 + h]; ba += lf[t]; bt[t] = ba; mt[t] = fmaxf(lf[t] + mp, ig[t]); mp = mt[t]; } }
    const float ml = mt[3], dec = __expf(bt[3] + m0 - ml);
    float q[4][2], k[4][2], vv[4][2], kw[4][2], n0[2];
#pragma unroll
    for (int t = 0; t < 4; ++t) {
        const bf16* qr = F.P + 1 * P_STRIDE + (size_t)(rowb + t) * 512 + h * HD; const bf16* kr = F.P + 2 * P_STRIDE + (size_t)(rowb + t) * 512 + h * HD; const bf16* vr = F.P + 3 * P_STRIDE + (size_t)(rowb + t) * 512 + h * HD;
        q[t][0] = bf2f(qr[lane]); q[t][1] = bf2f(qr[lane + 64]); k[t][0] = bf2f(kr[lane]); k[t][1] = bf2f(kr[lane + 64]);
        const unsigned vw = *(const unsigned*)(vr + 2 * lane); vv[t][0] = bflo(vw); vv[t][1] = bfhi(vw);
        const float ws = __expf(bt[3] - bt[t] + ig[t] - ml); kw[t][0] = ws * k[t][0]; kw[t][1] = ws * k[t][1];
    }
    n0[0] = F.state_n[task * HD + lane]; n0[1] = F.state_n[task * HD + lane + 64];
    float Pm[4][4], den[4], inter[4];
#pragma unroll
    for (int t = 0; t < 4; ++t) {
        inter[t] = __expf(bt[t] + m0 - mt[t]);
        float dsum = inter[t] * wave_sum(q[t][0] * n0[0] + q[t][1] * n0[1]);
#pragma unroll
        for (int s = 0; s < 4; ++s) { if (s <= t) { Pm[t][s] = wave_sum(q[t][0] * k[s][0] + q[t][1] * k[s][1]) * __expf(bt[t] - bt[s] + ig[s] - mt[t]); dsum += Pm[t][s]; } else Pm[t][s] = 0.f; }
        den[t] = fmaxf(fabsf(dsum), __expf(-mt[t]));
    }
    if (wave == 0) { F.out[O_NS + task * HD + lane] = dec * n0[0] + (kw[0][0] + kw[1][0]) + (kw[2][0] + kw[3][0]); F.out[O_NS + task * HD + lane + 64] = dec * n0[1] + (kw[0][1] + kw[1][1]) + (kw[2][1] + kw[3][1]);
        if (lane == 0) F.out[O_MS + task] = ml; }
    const float* Ci = F.state_C + (size_t)task * HD * HD; float* Co = F.out + O_CS + (size_t)task * HD * HD;
    float np[4][2];
#pragma unroll
    for (int t = 0; t < 4; ++t) { np[t][0] = 0.f; np[t][1] = 0.f; }
    f32x2 c2[16];
#pragma unroll
    for (int r = 0; r < 16; ++r) c2[r] = *(const f32x2*)(Ci + (size_t)(wave * 16 + r) * HD + 2 * lane);
    const bool hi = wave >= 4;
#pragma unroll
    for (int r = 0; r < 16; ++r) {
        const int sl = (wave * 16 + r) & 63;
        float o0 = dec * c2[r].x, o1 = dec * c2[r].y;
#pragma unroll
        for (int t = 0; t < 4; ++t) {
            const float qs = __builtin_bit_cast(float, __builtin_amdgcn_readlane(__builtin_bit_cast(int, hi ? q[t][1] : q[t][0]), sl));
            const float ks = __builtin_bit_cast(float, __builtin_amdgcn_readlane(__builtin_bit_cast(int, hi ? kw[t][1] : kw[t][0]), sl));
            o0 += ks * vv[t][0]; o1 += ks * vv[t][1]; np[t][0] += qs * c2[r].x; np[t][1] += qs * c2[r].y;
        }
        f32x2 o; o.x = o0; o.y = o1; *(f32x2*)(Co + (size_t)(wave * 16 + r) * HD + 2 * lane) = o;
    }
#pragma unroll
    for (int t = 0; t < 4; ++t) { f32x2 o; o.x = np[t][0]; o.y = np[t][1]; *(LAS f32x2*)(red + (wave * 4 + t) * HD + 2 * lane) = o; }
    __syncthreads();
#pragma unroll
    for (int t = 0; t < 4; ++t) if (wave == t) {
        float a0 = 0.f, a1 = 0.f;
#pragma unroll
        for (int w = 0; w < NWAVES; ++w) { const f32x2 x = *(const LAS f32x2*)(red + (w * 4 + t) * HD + 2 * lane); a0 += x.x; a1 += x.y; }
        a0 *= inter[t]; a1 *= inter[t];
#pragma unroll
        for (int s = 0; s < 4; ++s) if (s <= t) { a0 += Pm[t][s] * vv[s][0]; a1 += Pm[t][s] * vv[s][1]; }
        const float h0 = a0 / den[t], h1 = a1 / den[t];
        const float rn = 1.f / sqrtf(wave_sum(h0 * h0 + h1 * h1) * (1.f / HD) + EPS);
        const unsigned ow = *(const unsigned*)(F.P + 4 * P_STRIDE + (size_t)(rowb + t) * 512 + h * HD + 2 * lane);
        const f32x2 g = *(const f32x2*)(F.head_gain + h * HD + 2 * lane);
        *(unsigned*)(F.MIX + (size_t)(rowb + t) * D + PW + h * HD + 2 * lane) = pk2(h0 * rn * g.x * sigmoidf_(bflo(ow)), h1 * rn * g.y * sigmoidf_(bfhi(ow)));
    }
    __syncthreads();
}
__device__ __forceinline__ void p2_state(Frame& F) {
    if ((int)blockIdx.x < NB * NH) { s_chain(F, (int)blockIdx.x); return; }
    for (int task = (int)blockIdx.x - NB * NH; task < DECB * NH; task += F.G - NB * NH) s_sample_task(F, task);
}

__device__ __forceinline__ void mlstm_out_unit(Frame& F, int u) {
    const int lane = F.lane, wave = F.wave, tid = F.tid;
    const int i16 = lane & 15, q4 = i16 >> 2, p4 = i16 & 3, blk = (lane >> 4) & 1, hh = lane >> 5, r32 = lane & 31;
    {
        const int b = u >> 5, c = (u & 31) + 1, row0 = b * SEQ + (c - 1) * 64, p0 = NMETA + (c - 1) * 64;
        LAS float* sa = (LAS float*)(F.lds + 4 * IMG_BYTES);
#pragma unroll
        for (int i = 0; i < 8; ++i) { const int id = tid + 512 * i, row = id >> 6, cc = id & 63, hd = cc >> 4;
            const v4u w = *(const v4u*)(F.P + 3 * P_STRIDE + (size_t)(row0 + row) * 512 + cc * 8);
            *(LAS v4u*)(F.lds + hd * IMG_BYTES + row * IMG_STRIDE + (cc & 15) * 16) = w; }
        if (tid < 256) { const int hd = tid >> 6, s = tid & 63; sa[tid] = F.Gt[(size_t)(row0 + s) * 8 + hd] - F.SCB[(size_t)((b * 4 + hd)) * LP + p0 + s]; }
        __syncthreads();
        const int h = wave >> 1, th = wave & 1, bh = b * 4 + h;
        const int t = 32 * th + r32, row = row0 + t;
        const float bt = F.SCB[(size_t)bh * LP + p0 + t], mt = F.SCM[(size_t)bh * LP + p0 + t], m0c = F.M0[bh * 34 + c];
        const float ct = bt - mt, inter = __expf(bt + m0c - mt), emt = __expf(-mt);
        bf16x8 qf[8];
#pragma unroll
        for (int s = 0; s < 8; ++s) qf[s] = *(const bf16x8*)(F.P + 1 * P_STRIDE + (size_t)row * 512 + h * HD + 16 * s + 8 * hh);
        f32x16 OT[4];
#pragma unroll
        for (int vt = 0; vt < 4; ++vt)
#pragma unroll
            for (int i = 0; i < 16; ++i) OT[vt][i] = 0.f;
        const bf16* Cs = F.CST + ((size_t)(bh * 32 + (c - 1)) * HD) * HD;
#pragma unroll
        for (int vt = 0; vt < 4; ++vt)
#pragma unroll
            for (int s = 0; s < 8; ++s) { const bf16x8 A = *(const bf16x8*)(Cs + (size_t)(32 * vt + r32) * HD + 16 * s + 8 * hh); OT[vt] = MFMA32(A, qf[s], OT[vt]); }
#pragma unroll
        for (int vt = 0; vt < 4; ++vt)
#pragma unroll
            for (int i = 0; i < 16; ++i) OT[vt][i] *= inter;
        float qn = 0.f;
        { const float* Ns = F.NST + (size_t)(bh * 32 + (c - 1)) * HD;
#pragma unroll
          for (int s = 0; s < 8; ++s) { const f32x4 n0a = *(const f32x4*)(Ns + 16 * s + 8 * hh), n0b = *(const f32x4*)(Ns + 16 * s + 8 * hh + 4); const v4u qw = __builtin_bit_cast(v4u, qf[s]);
              qn += (bflo(qw.x) * n0a.x + bfhi(qw.x) * n0a.y) + (bflo(qw.y) * n0a.z + bfhi(qw.y) * n0a.w) + (bflo(qw.z) * n0b.x + bfhi(qw.z) * n0b.y) + (bflo(qw.w) * n0b.z + bfhi(qw.w) * n0b.w); } }
        qn += __shfl_xor(qn, 32);
        float csum = 0.f;
        const LAS unsigned char* vimg = F.lds + h * IMG_BYTES;
#pragma unroll
        for (int stile = 0; stile < 2; ++stile) if (stile <= th) {
            f32x16 ST;
#pragma unroll
            for (int i = 0; i < 16; ++i) ST[i] = 0.f;
#pragma unroll
            for (int s = 0; s < 8; ++s) { const bf16x8 A = *(const bf16x8*)(F.P + 2 * P_STRIDE + (size_t)(row0 + 32 * stile + r32) * 512 + h * HD + 16 * s + 8 * hh); ST = MFMA32(A, qf[s], ST); }
#pragma unroll
            for (int g = 0; g < 4; ++g) { const f32x4 as4 = *(const LAS f32x4*)(sa + h * 64 + 32 * stile + 8 * g + 4 * hh);
#pragma unroll
                for (int e = 0; e < 4; ++e) { const int sl = 32 * stile + 8 * g + 4 * hh + e; const float dv = (sl <= t) ? __expf(ct + as4[e]) : 0.f; const float pv = ST[4 * g + e] * dv; ST[4 * g + e] = pv; csum += pv; } }
#pragma unroll
            for (int ks = 0; ks < 2; ++ks) {
                v4u pw; pw.x = cvtpk(ST[8 * ks], ST[8 * ks + 1]); pw.y = cvtpk(ST[8 * ks + 2], ST[8 * ks + 3]); pw.z = cvtpk(ST[8 * ks + 4], ST[8 * ks + 5]); pw.w = cvtpk(ST[8 * ks + 6], ST[8 * ks + 7]);
                const bf16x8 Pf = __builtin_bit_cast(bf16x8, pw);
                const int rlo = 32 * stile + 16 * ks + 4 * hh + q4;
#pragma unroll
                for (int vt = 0; vt < 4; ++vt) { const bf16x8 A = cat8(vtr(vimg + rlo * IMG_STRIDE + 2 * (32 * vt + 16 * blk + 4 * p4)), vtr(vimg + (rlo + 8) * IMG_STRIDE + 2 * (32 * vt + 16 * blk + 4 * p4))); OT[vt] = MFMA32(A, Pf, OT[vt]); }
            }
        }
        csum += __shfl_xor(csum, 32);
        const float den = fmaxf(fabsf(inter * qn + csum), emt), rden = 1.f / den;
        float ss = 0.f;
#pragma unroll
        for (int vt = 0; vt < 4; ++vt)
#pragma unroll
            for (int i = 0; i < 16; ++i) { OT[vt][i] *= rden; ss += OT[vt][i] * OT[vt][i]; }
        ss += __shfl_xor(ss, 32);
        const float rn = 1.f / sqrtf(ss * (1.f / HD) + EPS);
#pragma unroll
        for (int vt = 0; vt < 4; ++vt)
#pragma unroll
            for (int g = 0; g < 4; ++g) { const int v0 = 32 * vt + 8 * g + 4 * hh;
                const f32x4 gn = *(const f32x4*)(F.head_gain + h * HD + v0); const v2u ow = *(const v2u*)(F.P + 4 * P_STRIDE + (size_t)row * 512 + h * HD + v0);
                v2u w; w.x = cvtpk(OT[vt][4 * g] * rn * gn.x * sigmoidf_(bflo(ow.x)), OT[vt][4 * g + 1] * rn * gn.y * sigmoidf_(bfhi(ow.x)));
                w.y = cvtpk(OT[vt][4 * g + 2] * rn * gn.z * sigmoidf_(bflo(ow.y)), OT[vt][4 * g + 3] * rn * gn.w * sigmoidf_(bfhi(ow.y)));
                *(v2u*)(F.MIX + (size_t)row * D + PW + h * HD + v0) = w; }
        __syncthreads();
    }
}

constexpr int PIMG_STRIDE = 1040;
template <int NT> __device__ __forceinline__ void pool_tokens(const v4u (&rw)[15 + NT], int g, LAS unsigned char* dst  ) {
    unsigned ow[NT][4];
#pragma unroll
    for (int k = 0; k < 4; ++k) {
        float lo[15 + NT], hi[15 + NT];
#pragma unroll
        for (int i = 0; i < 15 + NT; ++i) { const unsigned w = rw[i][k]; lo[i] = bflo(w); hi[i] = bfhi(w); }
#pragma unroll
        for (int t = 0; t < NT; ++t) { const int i = 15 + t;
            const float a2 = lo[i] + lo[i - 1], a4 = a2 + (lo[i - 2] + lo[i - 3]), a8 = a4 + ((lo[i - 4] + lo[i - 5]) + (lo[i - 6] + lo[i - 7]));
            const float a16 = a8 + (((lo[i - 8] + lo[i - 9]) + (lo[i - 10] + lo[i - 11])) + ((lo[i - 12] + lo[i - 13]) + (lo[i - 14] + lo[i - 15])));
            const float b2 = hi[i] + hi[i - 1], b4 = b2 + (hi[i - 2] + hi[i - 3]), b8 = b4 + ((hi[i - 4] + hi[i - 5]) + (hi[i - 6] + hi[i - 7]));
            const float b16 = b8 + (((hi[i - 8] + hi[i - 9]) + (hi[i - 10] + hi[i - 11])) + ((hi[i - 12] + hi[i - 13]) + (hi[i - 14] + hi[i - 15])));
            const float pa = (g == 0 ? a2 * 0.5f : g == 1 ? a4 * 0.25f : g == 2 ? a8 * 0.125f : a16 * 0.0625f) - lo[i];
            const float pb = (g == 0 ? b2 * 0.5f : g == 1 ? b4 * 0.25f : g == 2 ? b8 * 0.125f : b16 * 0.0625f) - hi[i];
            ow[t][k] = cvtpk(pa, pb); }
    }
#pragma unroll
    for (int t = 0; t < NT; ++t) { v4u w; w.x = ow[t][0]; w.y = ow[t][1]; w.z = ow[t][2]; w.w = ow[t][3]; *(LAS v4u*)(dst + t * PIMG_STRIDE) = w; }
}
__device__ __forceinline__ void pool_unit(Frame& F, int u) {
    const int lane = F.lane, wave = F.wave, hh = lane >> 5, r32 = lane & 31;
    const bf16* U = F.P;
    LAS unsigned char* pimg = F.lds;
    const int g_l = lane >> 4;
    int rowbase;
    if (u < NB * 32) {
        const int b = u >> 5, tr0 = (u & 31) * 64; rowbase = b * SEQ + tr0;
        v4u rw[23];
#pragma unroll
        for (int i = 0; i < 23; ++i) { const int tr = tr0 + 8 * wave - 15 + i; const int r = tr >= 0 ? b * SEQ + tr : R_META0 + NMETA + tr; rw[i] = *(const v4u*)(U + (size_t)r * 512 + 8 * lane); }
        pool_tokens<8>(rw, g_l, pimg + (8 * wave) * PIMG_STRIDE + 16 * lane);
    } else {
        const int su = u - NB * 32; rowbase = R_PROMPT + su * 64;
#pragma unroll
        for (int sq = 0; sq < 2; ++sq) { const int seq = su * 16 + 2 * wave + sq;
            v4u rw[19];
#pragma unroll
            for (int i = 0; i < 15; ++i) { const float* cr = F.state_pool + ((size_t)seq * 15 + i) * 512 + 8 * lane; const f32x4 x0 = *(const f32x4*)cr, x1 = *(const f32x4*)(cr + 4);
                rw[i].x = cvtpk(x0.x, x0.y); rw[i].y = cvtpk(x0.z, x0.w); rw[i].z = cvtpk(x1.x, x1.y); rw[i].w = cvtpk(x1.z, x1.w); }
#pragma unroll
            for (int i = 0; i < 4; ++i) rw[15 + i] = *(const v4u*)(U + (size_t)(R_PROMPT + seq * DECT + i) * 512 + 8 * lane);
            pool_tokens<4>(rw, g_l, pimg + (8 * wave + 4 * sq) * PIMG_STRIDE + 16 * lane); }
    }
    __syncthreads();
    const int g = wave >> 1, th = wave & 1;
    f32x16 acc[4];
#pragma unroll
    for (int dt = 0; dt < 4; ++dt)
#pragma unroll
        for (int i = 0; i < 16; ++i) acc[dt][i] = 0.f;
#pragma unroll
    for (int s = 0; s < 8; ++s) { const bf16x8 B = *(const LAS bf16x8*)(pimg + (32 * th + r32) * PIMG_STRIDE + 2 * (g * 128 + 16 * s + 8 * hh));
#pragma unroll
        for (int dt = 0; dt < 4; ++dt) { const bf16x8 A = *(const bf16x8*)(F.WpT + (size_t)(g * 128 + 32 * dt + r32) * 128 + 16 * s + 8 * hh); acc[dt] = MFMA32(A, B, acc[dt]); } }
    const int row = rowbase + 32 * th + r32;
#pragma unroll
    for (int dt = 0; dt < 4; ++dt)
#pragma unroll
        for (int gg = 0; gg < 4; ++gg) { const int d0 = g * 128 + 32 * dt + 8 * gg + 4 * hh; const f32x4 sc = *(const f32x4*)(F.pool_scale + d0);
            v2u w; w.x = cvtpk(acc[dt][4 * gg] * sc.x, acc[dt][4 * gg + 1] * sc.y); w.y = cvtpk(acc[dt][4 * gg + 2] * sc.z, acc[dt][4 * gg + 3] * sc.w);
            *(v2u*)(F.MIX + (size_t)row * D + d0) = w; }
    __syncthreads();
}
__device__ __forceinline__ void p3_out(Frame& F) {
    for (int u = (int)blockIdx.x; u < NB * 32 + R_SAMPLE / 64; u += F.G) {
        if (u < NB * 32) mlstm_out_unit(F, u);
        pool_unit(F, u);
    }
}

__device__ __forceinline__ void p3_poolstate(Frame& F) {
    const int gt = blockIdx.x * (NWAVES * 64) + F.tid, ngt = F.G * NWAVES * 64;
    for (int e = gt; e < NB * 15 * 512; e += ngt) { const int c = e & 511, i = (e >> 9) % 15, b = e / (15 * 512); F.out[O_POOLP + e] = bf2f(F.P[(size_t)(b * SEQ + SEQ - 15 + i) * 512 + c]); }
    for (int e = gt; e < DECB * 15 * 512; e += ngt) { const int c = e & 511, i = (e >> 9) % 15, b = e / (15 * 512);
        F.out[O_POOLS + e] = (i < 11) ? F.state_pool[((size_t)b * 15 + i + 4) * 512 + c] : bf2f(F.P[(size_t)(R_PROMPT + b * DECT + (i - 11)) * 512 + c]); }
}

__device__ __forceinline__ void p5_norm2(Frame& F) {
    for (int m = F.gw; m < R_MAIN; m += F.NGW) { f32x4 xn[4]; rms_row_to_bf16(F.out + O_Y + (size_t)m * D, F.norm2, F.XN + (size_t)m * D, F.lane, xn); }
}
__device__ __forceinline__ void p8_final(Frame& F) {
    for (int m = F.gw; m < R_MAIN; m += F.NGW) {
        GAS f32x4* xr = (GAS f32x4*)(F.out + O_Y + (size_t)m * D) + F.lane; const GAS f32x4* gr = (const GAS f32x4*)F.norm_f + F.lane;
        f32x4 v[4]; float s = 0.f;
#pragma unroll
        for (int j = 0; j < 4; ++j) { v[j] = xr[64 * j]; s += (v[j].x * v[j].x + v[j].y * v[j].y) + (v[j].z * v[j].z + v[j].w * v[j].w); }
        const float r = 1.f / sqrtf(wave_sum(s) * (1.f / D) + EPS);
#pragma unroll
        for (int j = 0; j < 4; ++j) xr[64 * j] = v[j] * r * gr[64 * j];
    }
}

struct Args { const float* in[18]; float* out; unsigned char* ws; int ph_lo, ph_hi; };
__global__ void __launch_bounds__(NWAVES * 64, 2) fwd_kernel(Args args) {
    extern __shared__ __attribute__((aligned(16))) unsigned char lds[];
    Frame F;
    F.lds = (LAS unsigned char*)lds;
    F.tid = threadIdx.x; F.lane = F.tid & 63; F.wave = __builtin_amdgcn_readfirstlane(F.tid >> 6);
    F.G = gridDim.x; F.gw = blockIdx.x * NWAVES + F.wave; F.NGW = F.G * NWAVES;
    F.x_prompt = args.in[0]; F.x_sample = args.in[1]; F.state_pool = args.in[2]; F.state_C = args.in[3]; F.state_n = args.in[4]; F.state_m = args.in[5]; F.meta = args.in[6]; F.norm1 = args.in[7];
    F.w_in = args.in[8]; F.b_gate = args.in[9]; F.w_pool = args.in[10]; F.pool_scale = args.in[11]; F.head_gain = args.in[12]; F.w_out = args.in[13]; F.norm2 = args.in[14]; F.w_up = args.in[15];
    F.w_down = args.in[16]; F.norm_f = args.in[17]; F.out = args.out;
    unsigned char* ws = args.ws;
    F.Win_t = (bf16*)(ws + WS_WIN); F.Wout_t = (bf16*)(ws + WS_WOUT); F.Wup_t = (bf16*)(ws + WS_WUP); F.Wdn_t = (bf16*)(ws + WS_WDN);
    F.Gt = (float*)(ws + WS_G); F.XN = (bf16*)(ws + WS_XN); F.P = (bf16*)(ws + WS_P); F.MIX = (bf16*)(ws + WS_MIX); F.CST = (bf16*)(ws + WS_CST); F.WpT = (bf16*)(ws + WS_WPT); F.NST = (float*)(ws + WS_NST); F.SCB = (float*)(ws + WS_SCB); F.SCM = (float*)(ws + WS_SCM); F.M0 = (float*)(ws + WS_M0); F.H = (bf16*)(ws + WS_H);
    for (int u = F.tid; u < (LDS_BYTES - RING_BYTES) / 4; u += NWAVES * 64) ((LAS unsigned*)(F.lds + RING_BYTES))[u] = 0u;
    __syncthreads();
    XcdBarrier bar = xcd_barrier_post((unsigned*)(ws + WS_CTL) + CW_BAR, (volatile LAS unsigned*)(F.lds + MISC_OFF) + 8);
    const int lo = args.ph_lo, hi = args.ph_hi;
#define IN(k) (lo <= (k) && (k) < hi)
#define GRID_BAR() xcd_barrier(bar)
    if (IN(0)) { p0_prologue(F); }
    if (IN(0) && IN(1)) GRID_BAR();
    if (IN(1)) { pg8::Gemm g{F.XN, F.Win_t, M_IN, NIN, D}; pg8::StaticOrder S; S.init(M_IN, NIN, F.G, (int)blockIdx.x);
        pg8::EpiIn E{F.P, P_STRIDE, 0.08838834764831845f};
        pg8::gemm_phase<pg8::EpiIn, pg8::StaticOrder, PG8_ALIGN, PG8_SP2>(F.lds, g, S, E); }
    if (IN(1) && IN(2)) GRID_BAR();
    if (IN(2)) { p2_state(F); }
    if (IN(2) && IN(3)) GRID_BAR();
    if (IN(3)) { p3_out(F); p3_poolstate(F); }
    if (IN(3) && IN(4)) GRID_BAR();
    if (IN(4)) { pg8::Gemm g{F.MIX, F.Wout_t, R_MAIN, D, D}; pg8::StaticOrder S; S.init(R_MAIN, D, F.G, (int)blockIdx.x);
        pg8::EpiRes E{F.x_prompt, F.x_sample, R_PROMPT / 256, F.out + O_Y};
        pg8::gemm_phase<pg8::EpiRes, pg8::StaticOrder, PG8_ALIGN, PG8_SP2>(F.lds, g, S, E); }
    if (IN(4) && IN(5)) GRID_BAR();
    if (IN(5)) { p5_norm2(F); }
    if (IN(5) && IN(6)) GRID_BAR();
    if (IN(6)) { pg8::Gemm g{F.XN, F.Wup_t, R_MAIN, FF, D}; pg8::StaticOrder S; S.init(R_MAIN, FF, F.G, (int)blockIdx.x);
        pg8::EpiRelu2 E{F.H, FF};
        pg8::gemm_phase<pg8::EpiRelu2, pg8::StaticOrder, PG8_ALIGN, PG8_SP2>(F.lds, g, S, E); }
    if (IN(6) && IN(7)) GRID_BAR();
    if (IN(7)) { pg8::Gemm g{F.H, F.Wdn_t, R_MAIN, D, FF}; pg8::StaticOrder S; S.init(R_MAIN, D, F.G, (int)blockIdx.x);
        pg8::EpiRes E{F.out + O_Y, F.out + O_Y, 1 << 20, F.out + O_Y};
        pg8::gemm_phase<pg8::EpiRes, pg8::StaticOrder, PG8_ALIGN, PG8_SP2>(F.lds, g, S, E); }
    if (IN(7) && IN(8)) GRID_BAR();
    if (IN(8)) { p8_final(F); }
#undef IN
#undef GRID_BAR
}

extern "C" void kernel_launch(void* const* d_in, const int* in_sizes, int n_in, void* d_out, int out_size, void* d_ws, size_t ws_size, hipStream_t stream) {
    static int grid = 0;
    if (grid == 0) {
        if (n_in != 18 || out_size != (int)O_END || ws_size < WS_END) { fprintf(stderr, "kernel_launch: unexpected shapes n_in %d out %d ws %zu\n", n_in, out_size, ws_size); grid = -1; return; }
        int dev = 0, cus = 0;
        if (hipGetDevice(&dev) != hipSuccess || hipDeviceGetAttribute(&cus, hipDeviceAttributeMultiprocessorCount, dev) != hipSuccess) { grid = -1; return; }
        if (hipFuncSetAttribute((const void*)fwd_kernel, hipFuncAttributeMaxDynamicSharedMemorySize, LDS_BYTES) != hipSuccess) { fprintf(stderr, "kernel_launch: hipFuncSetAttribute failed\n"); grid = -1; return; }
        grid = cus;
    }
    if (grid < 0) return;
    Args a{};
    for (int i = 0; i < 18; ++i) a.in[i] = (const float*)d_in[i];
    a.out = (float*)d_out; a.ws = (unsigned char*)d_ws;
    if (hipMemsetAsync((char*)d_ws + WS_CTL, 0, CTL_ZERO_BYTES, stream) != hipSuccess) { fprintf(stderr, "kernel_launch: memset failed\n"); return; }
    a.ph_lo = 0; a.ph_hi = 9; hipLaunchKernelGGL(fwd_kernel, dim3(grid), dim3(NWAVES * 64), LDS_BYTES, stream, a);
}
```

```cpp
#include <hip/hip_runtime.h>
#include <cstdio>
#include <cstdint>
namespace pg8 {
#define PG8_LAS __attribute__((address_space(3)))
typedef unsigned short bf16_t;
typedef short bf16x8 __attribute__((ext_vector_type(8)));
typedef float f32x4 __attribute__((ext_vector_type(4)));
typedef unsigned u32x4 __attribute__((ext_vector_type(4)));
constexpr int BM = 256, BK = 64, HALF = 128, HTB = HALF * BK * 2  , STAGE_BYTES = 8 * HTB, NXCD = 8, WGM = 8;

__host__ __device__ __forceinline__ int lds_byte(int r, int c) { const int st = (r >> 4) * 2 + (c >> 5), rr = r & 15, cc = c & 31, ob = rr * 64 + cc * 2; return st * 1024 + (ob ^ (((ob >> 9) & 1) << 5)); }
__host__ __device__ __forceinline__ void stage_rc(int b, int& R, int& C) { const int st = b / 1024, sb = b % 1024, swz = sb ^ (((sb >> 9) & 1) << 5); R = (st >> 1) * 16 + swz / 64; C = (st & 1) * 32 + (swz % 64) / 2; }
__host__ __device__ __forceinline__ int perm32(int rho) { const int n = rho >> 4, i = rho & 15; return 8 * (i >> 2) + 4 * n + (i & 3); }

struct Unit { int pm, pn; };
struct Gemm { const bf16_t* A; const bf16_t* Bt; int M, N, K; };

struct StaticOrder {
    int nM, nN, nwg, G, c;
    __host__ __device__ void init(int M, int N, int G_, int c_) { nM = M / BM; nN = N / BM; nwg = nM * nN; G = G_; c = c_; }
    __host__ __device__ bool next(int i, Unit& u) const {
        const long L = (long)i * G + c; if (L >= nwg) return false;
        int wgid = (int)L; { const int q = nwg / NXCD, r = nwg % NXCD, xcd = wgid % NXCD, off = wgid / NXCD; wgid = (xcd < r ? xcd * (q + 1) : r * (q + 1) + (xcd - r) * q) + off; }
        const int nig = WGM * nN, gid = wgid / nig, fm = gid * WGM, gsz = (nM - fm) < WGM ? (nM - fm) : WGM;
        u.pm = fm + ((wgid % nig) % gsz); u.pn = (wgid % nig) / gsz; return true;
    }
    __device__ __forceinline__ void a_ready(const Unit&) const {}
    __device__ __forceinline__ void done(const Unit&) const {}
};

__device__ __forceinline__ unsigned cvt_pk_bf16(float lo, float hi) { unsigned r; asm volatile("v_cvt_pk_bf16_f32 %0, %1, %2" : "=v"(r) : "v"(lo), "v"(hi)); return r; }

struct EpiIn {
    static constexpr bool PERM = true, AFTER_DRAIN = false;
    bf16_t* O; size_t split_stride; float qscale;
    __device__ __forceinline__ void operator()(const f32x4 (&acc)[2][2][4][2], const Unit& u, int wr, int wc, int fr, int fq) const {
        const int row0 = u.pm * BM + wr * 64 + fr; const int t = u.pn >> 1; const int colt = (u.pn & 1) * BM;
        bf16_t* base = O + (size_t)t * split_stride; const float sc = (t == 1) ? qscale : 1.f;
        const int col0 = colt + wc * 32 + 8 * fq;
#pragma unroll
        for (int ai = 0; ai < 2; ++ai)
#pragma unroll
            for (int m = 0; m < 4; ++m) { bf16_t* rowp = base + (size_t)(row0 + ai * HALF + m * 16) * 512 + col0;
#pragma unroll
                for (int bj = 0; bj < 2; ++bj) { f32x4 v0 = acc[ai][bj][m][0] * sc, v1 = acc[ai][bj][m][1] * sc;
                    u32x4 w; w.x = cvt_pk_bf16(v0[0], v0[1]); w.y = cvt_pk_bf16(v0[2], v0[3]); w.z = cvt_pk_bf16(v1[0], v1[1]); w.w = cvt_pk_bf16(v1[2], v1[3]);
                    *(u32x4*)(rowp + bj * HALF) = w; } }
    }
};
struct EpiRelu2 {
    static constexpr bool PERM = true, AFTER_DRAIN = false;
    bf16_t* O; int ldc;
    __device__ __forceinline__ void operator()(const f32x4 (&acc)[2][2][4][2], const Unit& u, int wr, int wc, int fr, int fq) const {
        const int row0 = u.pm * BM + wr * 64 + fr; const int col0 = u.pn * BM + wc * 32 + 8 * fq;
#pragma unroll
        for (int ai = 0; ai < 2; ++ai)
#pragma unroll
            for (int m = 0; m < 4; ++m) { bf16_t* rowp = O + (size_t)(row0 + ai * HALF + m * 16) * ldc + col0;
#pragma unroll
                for (int bj = 0; bj < 2; ++bj) { f32x4 v0 = acc[ai][bj][m][0], v1 = acc[ai][bj][m][1];
#pragma unroll
                    for (int e = 0; e < 4; ++e) { const float a = fmaxf(v0[e], 0.f), b = fmaxf(v1[e], 0.f); v0[e] = a * a; v1[e] = b * b; }
                    u32x4 w; w.x = cvt_pk_bf16(v0[0], v0[1]); w.y = cvt_pk_bf16(v0[2], v0[3]); w.z = cvt_pk_bf16(v1[0], v1[1]); w.w = cvt_pk_bf16(v1[2], v1[3]);
                    *(u32x4*)(rowp + bj * HALF) = w; } }
    }
};
struct EpiRes {
    static constexpr bool PERM = false, AFTER_DRAIN = false;
    const float* resA; const float* resB; int split_pm; float* out;
    __device__ __forceinline__ void operator()(const f32x4 (&acc)[2][2][4][2], const Unit& u, int wr, int wc, int fr, int fq) const {
        const int row0 = u.pm * BM + wr * 64 + fr, col0 = u.pn * BM + wc * 32 + 4 * fq;
        const float* res = (u.pm < split_pm) ? resA : (resB - (size_t)split_pm * BM * 1024);
#pragma unroll
        for (int ai = 0; ai < 2; ++ai)
#pragma unroll
            for (int m = 0; m < 4; ++m) { const size_t off = (size_t)(row0 + ai * HALF + m * 16) * 1024 + col0;
#pragma unroll
                for (int bj = 0; bj < 2; ++bj)
#pragma unroll
                    for (int n = 0; n < 2; ++n) { const f32x4 r = *(const f32x4*)(res + off + bj * HALF + n * 16); *(f32x4*)(out + off + bj * HALF + n * 16) = r + acc[ai][bj][m][n]; } }
    }
};

template <class Epi, class Sched, bool ALIGN_EPI = false, bool SP2 = false>
__device__ __forceinline__ void gemm_phase(PG8_LAS unsigned char* lds, const Gemm g, const Sched& S, const Epi& E) {
    const int tid = threadIdx.x, wid = __builtin_amdgcn_readfirstlane(tid >> 6), lane = tid & 63, wr = wid >> 2, wc = wid & 3, fr = lane & 15, fq = lane >> 4;
    const int K = g.K, nt = K / BK;
    unsigned voffA[2], voffB[2];
#pragma unroll
    for (int i = 0; i < 2; ++i) { int R, C; stage_rc(tid * 16 + i * 8192, R, C); const int Rb = Epi::PERM ? ((R & ~31) + perm32(R & 31)) : R;
        voffA[i] = (unsigned)(R * K + C) * 2u; voffB[i] = (unsigned)(Rb * K + C) * 2u; }
    const size_t kstep = (size_t)(BK * 2);
    const size_t hstep = (size_t)HALF * K * 2;
    const size_t tstep = 2 * hstep;
    const unsigned ldsw = (unsigned)wid * 1024u;
    const int aoff = lds_byte(wr * 64 + fr, fq * 8), boff = lds_byte(wc * 32 + fr, fq * 8);
#define PG8_SA(b, h) (((b) * 2 + (h)) * HTB)
#define PG8_SB(b, h) ((4 + (b) * 2 + (h)) * HTB)
#define PG8_STAGE(bufoff, gbase, voff) do { _Pragma("unroll") for (int _i = 0; _i < 2; ++_i) \
        __builtin_amdgcn_global_load_lds((const unsigned*)((const char*)(gbase) + (voff)[_i]), (PG8_LAS unsigned*)(lds + (bufoff) + ldsw + _i * 8192), 16, 0, 0); } while (0)
#define PG8_LDA(dst, b, h) do { _Pragma("unroll") for (int m = 0; m < 4; ++m) _Pragma("unroll") for (int k = 0; k < 2; ++k) dst[m][k] = *(const PG8_LAS bf16x8*)(lds + PG8_SA(b, h) + aoff + m * 2048 + k * 1024); } while (0)
#define PG8_LDB(dst, b, h) do { _Pragma("unroll") for (int n = 0; n < 2; ++n) _Pragma("unroll") for (int k = 0; k < 2; ++k) dst[n][k] = *(const PG8_LAS bf16x8*)(lds + PG8_SB(b, h) + boff + n * 2048 + k * 1024); } while (0)
#define PG8_MMA(ai, bj, At, Bt) do { __builtin_amdgcn_s_setprio(1); _Pragma("unroll") for (int m = 0; m < 4; ++m) _Pragma("unroll") for (int n = 0; n < 2; ++n) _Pragma("unroll") for (int k = 0; k < 2; ++k) \
        acc[ai][bj][m][n] = __builtin_amdgcn_mfma_f32_16x16x32_bf16(Bt[n][k], At[m][k], acc[ai][bj][m][n], 0, 0, 0); __builtin_amdgcn_s_setprio(0); } while (0)
#define PG8_WAIT_V(n) asm volatile("s_waitcnt vmcnt(" #n ")" ::: "memory")
#define PG8_WAIT_L(n) asm volatile("s_waitcnt lgkmcnt(" #n ")" ::: "memory")
#define PG8_BAR __builtin_amdgcn_s_barrier()
#define PG8_SCHED __builtin_amdgcn_sched_barrier(0)
    Unit cur, nxt; int ui = 0;
    if (!S.next(0, cur)) return;
    f32x4 acc[2][2][4][2];
#pragma unroll
    for (int a = 0; a < 2; ++a)
#pragma unroll
        for (int b = 0; b < 2; ++b)
#pragma unroll
            for (int m = 0; m < 4; ++m)
#pragma unroll
                for (int n = 0; n < 2; ++n) acc[a][b][m][n] = (f32x4){0.f, 0.f, 0.f, 0.f};
    bf16x8 At[4][2], B0[2][2], B1[2][2];
    const char* cA = (const char*)g.A + (size_t)cur.pm * tstep; const char* cB = (const char*)g.Bt + (size_t)cur.pn * tstep;
    S.a_ready(cur);
    if constexpr (SP2) {
        PG8_STAGE(PG8_SB(0, 0), cB, voffB); PG8_STAGE(PG8_SB(0, 1), cB + hstep, voffB); PG8_STAGE(PG8_SA(0, 0), cA, voffA); PG8_STAGE(PG8_SA(0, 1), cA + hstep, voffA);
        if (wr == 1) PG8_BAR;
        PG8_WAIT_V(2); PG8_BAR;
        PG8_STAGE(PG8_SB(1, 0), cB + kstep, voffB); PG8_STAGE(PG8_SA(1, 0), cA + kstep, voffA); PG8_STAGE(PG8_SB(1, 1), cB + hstep + kstep, voffB);
        PG8_WAIT_V(6); PG8_BAR;
    } else {
        PG8_STAGE(PG8_SB(0, 0), cB, voffB); PG8_STAGE(PG8_SA(0, 0), cA, voffA); PG8_STAGE(PG8_SB(0, 1), cB + hstep, voffB); PG8_STAGE(PG8_SA(0, 1), cA + hstep, voffA);
        if (wr == 1) PG8_BAR;
        PG8_WAIT_V(4); PG8_BAR;
        PG8_STAGE(PG8_SB(1, 0), cB + kstep, voffB); PG8_STAGE(PG8_SA(1, 0), cA + kstep, voffA); PG8_STAGE(PG8_SB(1, 1), cB + hstep + kstep, voffB);
        PG8_WAIT_V(6); PG8_BAR;
    }
    for (;;) {
        const bool has_next = S.next(ui + 1, nxt);
        const char* nA = has_next ? (const char*)g.A + (size_t)nxt.pm * tstep : cA; const char* nB = has_next ? (const char*)g.Bt + (size_t)nxt.pn * tstep : cB;
        for (int t = 0; t < nt; t += 2) {
            const bool last = (t == nt - 2);
            const char* a1 = cA + (size_t)(t + 1) * kstep;
            const char* a2 = last ? nA : cA + (size_t)(t + 2) * kstep; const char* b2 = last ? nB : cB + (size_t)(t + 2) * kstep;
            const char* a3 = a2 + kstep; const char* b3 = b2 + kstep;
            if (last && has_next) S.a_ready(nxt);
            if constexpr (SP2) {
            PG8_LDB(B0, 0, 0); PG8_LDB(B1, 0, 1); PG8_SCHED; PG8_LDA(At, 0, 0); PG8_STAGE(PG8_SA(1, 1), a1 + hstep, voffA);
            PG8_WAIT_V(8); PG8_WAIT_L(0); PG8_BAR; PG8_MMA(0, 0, At, B0); PG8_MMA(0, 1, At, B1); PG8_BAR; PG8_SCHED;
            PG8_LDA(At, 0, 1); PG8_STAGE(PG8_SB(0, 0), b2, voffB); PG8_STAGE(PG8_SB(0, 1), b2 + hstep, voffB); PG8_STAGE(PG8_SA(0, 0), a2, voffA);
            PG8_WAIT_V(8); PG8_WAIT_L(0); PG8_BAR; PG8_MMA(1, 0, At, B0); PG8_MMA(1, 1, At, B1); PG8_BAR; PG8_SCHED;
            PG8_LDB(B0, 1, 0); PG8_LDB(B1, 1, 1); PG8_SCHED; PG8_LDA(At, 1, 0); PG8_STAGE(PG8_SA(0, 1), a2 + hstep, voffA);
            PG8_WAIT_V(8); PG8_WAIT_L(0); PG8_BAR; PG8_MMA(0, 0, At, B0); PG8_MMA(0, 1, At, B1); PG8_BAR; PG8_SCHED;
            PG8_LDA(At, 1, 1); PG8_STAGE(PG8_SB(1, 0), b3, voffB); PG8_STAGE(PG8_SB(1, 1), b3 + hstep, voffB); PG8_STAGE(PG8_SA(1, 0), a3, voffA);
            PG8_WAIT_V(8); PG8_WAIT_L(0); PG8_BAR; PG8_MMA(1, 0, At, B0); PG8_MMA(1, 1, At, B1); PG8_BAR; PG8_SCHED;
            } else {
            PG8_LDB(B0, 0, 0); PG8_SCHED; PG8_LDA(At, 0, 0); PG8_STAGE(PG8_SA(1, 1), a1 + hstep, voffA);
            PG8_WAIT_L(8); PG8_BAR; PG8_WAIT_L(0); PG8_MMA(0, 0, At, B0); PG8_BAR; PG8_SCHED;
            PG8_LDB(B1, 0, 1); PG8_STAGE(PG8_SB(0, 0), b2, voffB);
            PG8_BAR; PG8_WAIT_L(0); PG8_MMA(0, 1, At, B1); PG8_BAR;
            PG8_LDA(At, 0, 1); PG8_STAGE(PG8_SA(0, 0), a2, voffA);
            PG8_BAR; PG8_WAIT_L(0); PG8_MMA(1, 0, At, B0); PG8_BAR; PG8_SCHED;
            PG8_STAGE(PG8_SB(0, 1), b2 + hstep, voffB);
            PG8_WAIT_V(6); PG8_BAR; PG8_MMA(1, 1, At, B1); PG8_BAR;
            PG8_LDB(B0, 1, 0); PG8_SCHED; PG8_LDA(At, 1, 0); PG8_STAGE(PG8_SA(0, 1), a2 + hstep, voffA);
            PG8_WAIT_L(8); PG8_BAR; PG8_WAIT_L(0); PG8_MMA(0, 0, At, B0); PG8_BAR; PG8_SCHED;
            PG8_LDB(B1, 1, 1); PG8_STAGE(PG8_SB(1, 0), b3, voffB);
            PG8_BAR; PG8_WAIT_L(0); PG8_MMA(0, 1, At, B1); PG8_BAR;
            PG8_LDA(At, 1, 1); PG8_STAGE(PG8_SA(1, 0), a3, voffA);
            PG8_BAR; PG8_WAIT_L(0); PG8_MMA(1, 0, At, B0); PG8_BAR; PG8_SCHED;
            PG8_STAGE(PG8_SB(1, 1), b3 + hstep, voffB);
            PG8_WAIT_V(6); PG8_BAR; PG8_MMA(1, 1, At, B1); PG8_BAR;
            }
        }
        if constexpr (ALIGN_EPI) { if (wr == 0) PG8_BAR; }
        if constexpr (!Epi::AFTER_DRAIN) { E(acc, cur, wr, wc, fr, fq); S.done(cur); }
        if (!has_next) break;
#pragma unroll
        for (int a = 0; a < 2; ++a)
#pragma unroll
            for (int b = 0; b < 2; ++b)
#pragma unroll
                for (int m = 0; m < 4; ++m)
#pragma unroll
                    for (int n = 0; n < 2; ++n) acc[a][b][m][n] = (f32x4){0.f, 0.f, 0.f, 0.f};
        cur = nxt; cA = nA; cB = nB; ++ui;
        if constexpr (ALIGN_EPI) { if (wr == 1) PG8_BAR; }
    }
    PG8_WAIT_V(0);
    if constexpr (!ALIGN_EPI) { if (wr == 0) PG8_BAR; }
    PG8_BAR;
    if constexpr (Epi::AFTER_DRAIN) { E.fused(acc, cur, wr, wc, fr, fq, lds, wid, lane); S.done(cur); }
#undef PG8_SA
#undef PG8_SB
#undef PG8_STAGE
#undef PG8_LDA
#undef PG8_LDB
#undef PG8_MMA
#undef PG8_WAIT_V
#undef PG8_WAIT_L
#undef PG8_BAR
#undef PG8_SCHED
}
}
#ifndef PG8_SP2
#define PG8_SP2 true
#endif
#ifndef PG8_ALIGN
#define PG8_ALIGN true
#endif
constexpr int NWAVES = 8;
constexpr int D = 1024, NB = 8, SEQ = 2048, DECB = 128, DECT = 4, NMETA = 16;
constexpr int PW = 512, NH = 4, HD = 128, FF = 4096, INC = 2568, NIN = 2560;
constexpr int R_PROMPT = NB * SEQ;
constexpr int R_SAMPLE = DECB * DECT;
constexpr int R_MAIN = R_PROMPT + R_SAMPLE;
constexpr int R_META0 = R_MAIN;
constexpr int R_IN = R_MAIN + NMETA;
constexpr int M_IN = 17152;
constexpr int LP = SEQ + NMETA;
constexpr float EPS = 1e-6f;
constexpr size_t MiB = 1u << 20;
constexpr size_t WS_CTL = 0, CTL_ZERO_BYTES = 1 * MiB;
constexpr int CW_BAR = 4096;
constexpr size_t WS_WIN = 1 * MiB, WS_WOUT = 6 * MiB, WS_WUP = 8 * MiB, WS_WDN = 16 * MiB;
constexpr size_t WS_G = 24 * MiB;
constexpr size_t WS_XN = 25 * MiB;
constexpr size_t WS_P = 59 * MiB;
constexpr size_t P_STRIDE = (size_t)M_IN * 512;
constexpr size_t WS_MIX = 143 * MiB;
constexpr size_t WS_CST = 176 * MiB;
constexpr size_t WS_NST = 208 * MiB;
constexpr size_t WS_SCB = 208 * MiB + 512 * 1024;
constexpr size_t WS_SCM = WS_SCB + 288 * 1024;
constexpr size_t WS_M0 = WS_SCM + 288 * 1024;
constexpr size_t WS_WSA = WS_M0 + 8 * 1024;
constexpr size_t WS_DEC = WS_WSA + 288 * 1024;
constexpr size_t WS_WORAW = WS_DEC + 8 * 1024;
constexpr size_t WS_H = 59 * MiB;
constexpr size_t WS_END = 212 * MiB;
static_assert(WS_P + 5 * P_STRIDE * 2 <= WS_MIX && WS_MIX + (size_t)R_MAIN * 1024 * 2 <= WS_CST && WS_WORAW + 1024 * 512 * 2 <= WS_END && WS_H + (size_t)R_MAIN * FF * 2 <= WS_END, "d_ws map");
constexpr size_t O_Y = 0, O_POOLP = 17301504, O_CP = 17362944, O_NP = 17887232, O_MP = 17891328, O_POOLS = 17891360, O_CS = 18874400, O_NS = 27263008, O_MS = 27328544, O_END = 27329056;
constexpr int RING_BYTES = 131072, LDS_BYTES = 147456, MISC_OFF = RING_BYTES + 320;

#define GAS __attribute__((address_space(1)))
#define LAS __attribute__((address_space(3)))
typedef unsigned short bf16;
typedef unsigned v4u __attribute__((ext_vector_type(4)));
typedef unsigned v2u __attribute__((ext_vector_type(2)));
typedef float f32x4 __attribute__((ext_vector_type(4)));
typedef float f32x2 __attribute__((ext_vector_type(2)));
#define LDS_WAIT() asm volatile("s_waitcnt lgkmcnt(0)" ::: "memory")
#define VM_WAIT() asm volatile("s_waitcnt vmcnt(0)" ::: "memory")
__device__ __forceinline__ unsigned f2bf(float f) { unsigned u = __builtin_bit_cast(unsigned, f); return (u + 0x7fffu + ((u >> 16) & 1u)) >> 16; }
__device__ __forceinline__ unsigned pk2(float lo, float hi) { return f2bf(lo) | (f2bf(hi) << 16); }
__device__ __forceinline__ float bf2f(unsigned short b) { return __builtin_bit_cast(float, (unsigned)b << 16); }
__device__ __forceinline__ float bflo(unsigned w) { return __builtin_bit_cast(float, w << 16); }
__device__ __forceinline__ float bfhi(unsigned w) { return __builtin_bit_cast(float, w & 0xffff0000u); }
__device__ __forceinline__ float wave_sum(float v) {
#pragma unroll
    for (int o = 1; o < 64; o <<= 1) v += __shfl_xor(v, o);
    return v;
}
__device__ __forceinline__ float sigmoidf_(float x) { return 1.f / (1.f + __expf(-x)); }
__device__ __forceinline__ float logsigmoidf_(float x) { return fminf(x, 0.f) - log1pf(expf(-fabsf(x))); }

#define XB_TMO      128
#define XB_XCNT(j)  (256  + 64 * (j))
#define XB_XSUB(j)  (1280 + 64 * (j))
#define XB_XGEN(j)  (2304 + 64 * (j))
#define XB_TOP      3328
#define XB_TOPGEN   3392
#define XCD_BAR_WORDS 3456
#define XB_SPIN_CAP (1u << 18)

__device__ __forceinline__ unsigned xb_ld(unsigned* p)              { return __hip_atomic_load(p, __ATOMIC_RELAXED, __HIP_MEMORY_SCOPE_AGENT); }
__device__ __forceinline__ unsigned xb_add(unsigned* p, unsigned v) { return __hip_atomic_fetch_add(p, v, __ATOMIC_RELAXED, __HIP_MEMORY_SCOPE_AGENT); }
__device__ __forceinline__ unsigned xb_xcc_id() { return (unsigned)__builtin_amdgcn_s_getreg((3 << 11) | 20) & 0xFu; }
#define XB_SPIN(cond, bar) do { unsigned _sp = 0; while (cond) { __builtin_amdgcn_s_sleep(1); \
    if ((++_sp & 255u) == 0u) { if (xb_ld(&(bar)[XB_TMO])) break; if (_sp > XB_SPIN_CAP) { atomicAdd(&(bar)[XB_TMO], 1u); break; } } } } while (0)

struct XcdBarrier {
    unsigned* bar; unsigned x;
    volatile LAS unsigned* st;
};

__device__ __forceinline__ XcdBarrier xcd_barrier_post(unsigned* bar, volatile LAS unsigned* st) {
    XcdBarrier b; b.bar = bar; b.x = xb_xcc_id(); b.st = st;
    if (threadIdx.x == 0) (void)xb_add(&bar[XB_XCNT(b.x)], 1u);
    return b;
}
__device__ __forceinline__ void xcd_barrier_complete(unsigned* bar, unsigned x, unsigned& nloc, unsigned& nx) {
    const unsigned G = gridDim.x * gridDim.y * gridDim.z;
    unsigned sum, cnt, mine, sp = 0u;
    for (;;) {
        sum = 0u; cnt = 0u; mine = 0u;
#pragma unroll
        for (unsigned j = 0; j < 16; ++j) { const unsigned c = xb_ld(&bar[XB_XCNT(j)]); sum += c; cnt += (c > 0u) ? 1u : 0u; mine = (j == x) ? c : mine; }
        if (sum == G) break;
        __builtin_amdgcn_s_sleep(1);
        if ((++sp & 255u) == 0u) { if (xb_ld(&bar[XB_TMO])) break; if (sp > XB_SPIN_CAP) { atomicAdd(&bar[XB_TMO], 1u); break; } }
    }
    nloc = mine > 0u ? mine : 1u; nx = cnt > 0u ? cnt : 1u;
}

__device__ __forceinline__ void xcd_barrier(const XcdBarrier& b) {
    asm volatile("s_waitcnt vmcnt(0)" ::: "memory");
    __syncthreads();
    if (threadIdx.x == 0) {
        unsigned* bar = b.bar;
        __builtin_amdgcn_s_waitcnt(0);
        unsigned nloc = b.st[0], nx = b.st[1];
        if (nloc == 0u) { xcd_barrier_complete(bar, b.x, nloc, nx); b.st[0] = nloc; b.st[1] = nx; }
        const unsigned old = xb_add(&bar[XB_XSUB(b.x)], 1u);
        const unsigned gen = old / nloc;
        if (old + 1u == (gen + 1u) * nloc) {
            __builtin_amdgcn_fence(__ATOMIC_RELEASE, "agent");
            asm volatile("s_waitcnt vmcnt(0)" ::: "memory");
            const unsigned og = xb_add(&bar[XB_TOP], 1u);
            const unsigned tg = og / nx;
            if (og + 1u == (tg + 1u) * nx) xb_add(&bar[XB_TOPGEN], 1u);
            else XB_SPIN(xb_ld(&bar[XB_TOPGEN]) == tg, bar);
            __builtin_amdgcn_fence(__ATOMIC_ACQUIRE, "agent");
            xb_add(&bar[XB_XGEN(b.x)], 1u);
            asm volatile("s_waitcnt vmcnt(0)" ::: "memory");
        } else {
            XB_SPIN(xb_ld(&bar[XB_XGEN(b.x)]) == gen, bar);
            __builtin_amdgcn_fence(__ATOMIC_ACQUIRE, "agent");
            asm volatile("s_waitcnt vmcnt(0)" ::: "memory");
        }
    }
    __syncthreads();
}

struct Frame {
    LAS unsigned char* lds;
    int tid, lane, wave, G, gw, NGW;
    const float *x_prompt, *x_sample, *state_pool, *state_C, *state_n, *state_m, *meta, *norm1, *w_in, *b_gate, *w_pool, *pool_scale, *head_gain, *w_out, *norm2, *w_up, *w_down, *norm_f;
    float* out;
    bf16 *Win_t, *Wout_t, *Wup_t, *Wdn_t, *XN, *P, *MIX, *H;
    float *Gt, *NST, *SCB, *SCM, *M0, *WS, *DEC;
    bf16 *CST, *WoRaw;
};

__device__ __forceinline__ void p0_transpose_item(const float* W, int ldw, int ncols, bf16* WT, int ldt, const float* rowscale, LAS float* scr, int item, int lane) {
    const int nblk = ncols / 32, kb = item / nblk, nb = item % nblk, k0 = 64 * kb, n0 = 32 * nb;
#pragma unroll 8
    for (int i = 0; i < 32; ++i) { const int kk = 2 * i + (lane >> 5); float w = W[(size_t)(k0 + kk) * ldw + n0 + (lane & 31)]; if (rowscale) w *= rowscale[k0 + kk]; scr[kk * 33 + (lane & 31)] = w; }
    LDS_WAIT(); asm volatile("" ::: "memory");
    const int c = lane & 7;
#pragma unroll
    for (int j = 0; j < 4; ++j) { const int n = (lane >> 3) + 8 * j; const LAS float* s = scr + (8 * c) * 33 + n;
        v4u o; o.x = pk2(s[0 * 33], s[1 * 33]); o.y = pk2(s[2 * 33], s[3 * 33]); o.z = pk2(s[4 * 33], s[5 * 33]); o.w = pk2(s[6 * 33], s[7 * 33]);
        *(GAS v4u*)(WT + (size_t)(n0 + n) * ldt + k0 + 8 * c) = o; }
    LDS_WAIT(); asm volatile("" ::: "memory");
}
__device__ __forceinline__ const float* in_row_ptr(const Frame& F, int r) {
    return r < R_PROMPT ? F.x_prompt + (size_t)r * D : (r < R_MAIN ? F.x_sample + (size_t)(r - R_PROMPT) * D : F.meta + (size_t)(r - R_META0) * D);
}
__device__ __forceinline__ void rms_row_to_bf16(const float* xrow, const float* g, bf16* orow, int lane, f32x4 (&xn)[4]) {
    const GAS f32x4* xr = (const GAS f32x4*)xrow + lane; const GAS f32x4* gr = (const GAS f32x4*)g + lane;
    float s = 0.f;
#pragma unroll
    for (int j = 0; j < 4; ++j) { xn[j] = xr[64 * j]; s += (xn[j].x * xn[j].x + xn[j].y * xn[j].y) + (xn[j].z * xn[j].z + xn[j].w * xn[j].w); }
    const float r = 1.f / sqrtf(wave_sum(s) * (1.f / D) + EPS);
    GAS v2u* o8 = (GAS v2u*)orow + lane;
#pragma unroll
    for (int j = 0; j < 4; ++j) { xn[j] = xn[j] * r * gr[64 * j]; v2u w; w.x = pk2(xn[j].x, xn[j].y); w.y = pk2(xn[j].z, xn[j].w); o8[64 * j] = w; }
}
__device__ __forceinline__ void p0_prologue(Frame& F) {
    LAS float* scr = (LAS float*)(F.lds + F.wave * 8448);
    LAS float* wgL = (LAS float*)(F.lds + 69632);
    for (int e = F.tid; e < 8 * D; e += NWAVES * 64) { const int g = e >> 10, k = e & 1023; wgL[e] = F.w_in[(size_t)k * INC + NIN + g]; }
    constexpr int I_IN = (D / 64) * (NIN / 32), I_OT = (PW / 64) * (D / 32), I_OB = I_OT, I_UP = (D / 64) * (FF / 32), I_DN = (FF / 64) * (D / 32);
    constexpr int NITEMS = I_IN + I_OT + I_OB + I_UP + I_DN;
    for (int it = F.gw; it < NITEMS; it += F.NGW) {
        int r = it;
        if (r < I_IN) { p0_transpose_item(F.w_in, INC, NIN, F.Win_t, D, nullptr, scr, r, F.lane); continue; } r -= I_IN;
        if (r < I_OT) { p0_transpose_item(F.w_out, D, D, F.WoRaw, PW, nullptr, scr, r, F.lane); continue; } r -= I_OT;
        if (r < I_OB) { p0_transpose_item(F.w_out + (size_t)PW * D, D, D, F.Wout_t + PW, D, F.head_gain, scr, r, F.lane); continue; } r -= I_OB;
        if (r < I_UP) { p0_transpose_item(F.w_up, FF, FF, F.Wup_t, D, nullptr, scr, r, F.lane); continue; } r -= I_UP;
        p0_transpose_item(F.w_down, D, D, F.Wdn_t, FF, nullptr, scr, r, F.lane);
    }
    __syncthreads();
    for (int m = F.gw; m < M_IN; m += F.NGW) {
        bf16* orow = F.XN + (size_t)m * D;
        if (m >= R_IN) { GAS v2u* o8 = (GAS v2u*)orow + F.lane; v2u z; z.x = 0u; z.y = 0u;
#pragma unroll
            for (int j = 0; j < 4; ++j) o8[64 * j] = z;
            if (F.lane < 8) F.Gt[(size_t)m * 8 + F.lane] = 0.f;
            continue; }
        f32x4 xn[4];
        rms_row_to_bf16(in_row_ptr(F, m), F.norm1, orow, F.lane, xn);
        float gs[8];
#pragma unroll
        for (int g = 0; g < 8; ++g) { float s = 0.f;
#pragma unroll
            for (int j = 0; j < 4; ++j) { const f32x4 w = *(const LAS f32x4*)(wgL + g * D + 4 * F.lane + 256 * j); s += (xn[j].x * w.x + xn[j].y * w.y) + (xn[j].z * w.z + xn[j].w * w.w); }
            gs[g] = wave_sum(s); }
        float val = gs[0];
#pragma unroll
        for (int g = 1; g < 8; ++g) val = (F.lane == g) ? gs[g] : val;
        if (F.lane < 8) { val += F.b_gate[F.lane]; F.Gt[(size_t)m * 8 + F.lane] = (F.lane < 4) ? val : logsigmoidf_(val); }
    }
}

typedef short bf16x8 __attribute__((ext_vector_type(8)));
typedef short s16x4 __attribute__((ext_vector_type(4)));
typedef float f32x16 __attribute__((ext_vector_type(16)));
#define MFMA32(a, b, c) __builtin_amdgcn_mfma_f32_32x32x16_bf16((a), (b), (c), 0, 0, 0)
__device__ __forceinline__ s16x4 vtr(const LAS unsigned char* p) { return __builtin_bit_cast(s16x4, __builtin_amdgcn_ds_read_tr16_b64_v4i16((LAS s16x4*)p)); }
__device__ __forceinline__ bf16x8 cat8(s16x4 lo, s16x4 hi) { return __builtin_shufflevector(lo, hi, 0, 1, 2, 3, 4, 5, 6, 7); }
__device__ __forceinline__ unsigned cvtpk(float lo, float hi) { typedef __bf16 bf16x2_t __attribute__((ext_vector_type(2))); f32x2 v = {lo, hi}; bf16x2_t b = __builtin_convertvector(v, bf16x2_t); return __builtin_bit_cast(unsigned, b); }
constexpr int IMG_STRIDE = 320;
constexpr int IMG_BYTES = 64 * IMG_STRIDE;
__device__ __forceinline__ int chunk_T(int c) { return c ? 64 : 16; }
__device__ __forceinline__ int chunk_p0(int c) { return c ? NMETA + (c - 1) * 64 : 0; }
__device__ __forceinline__ int chunk_row0(int b, int c) { return c ? b * SEQ + (c - 1) * 64 : R_META0; }

__device__ __forceinline__ void s_scan(Frame& F, int bh) {
    const int b = bh >> 2, h = bh & 3, tid = F.tid, lane = F.lane, wave = F.wave;
    LAS float* sb = (LAS float*)F.lds; LAS float* sg = sb + 2080; LAS float* sig = sg + 2080; LAS float* sB = sig + 2080; LAS float* sMl = sB + 40; LAS float* sm0 = sMl + 40;
    for (int c = wave; c < 33; c += NWAVES) {
        const int T = chunk_T(c), p0 = chunk_p0(c), row0 = chunk_row0(b, c);
        float lf = 0.f, ig = -INFINITY;
        if (lane < T) { lf = F.Gt[(size_t)(row0 + lane) * 8 + 4 + h]; ig = F.Gt[(size_t)(row0 + lane) * 8 + h]; }
        float bs = lf;
#pragma unroll
        for (int o = 1; o < 64; o <<= 1) { const float t = __shfl_up(bs, o); if (lane >= o) bs += t; }
        float g = ig - bs;
#pragma unroll
        for (int o = 1; o < 64; o <<= 1) { const float t = __shfl_up(g, o); if (lane >= o) g = fmaxf(g, t); }
        if (lane < T) { sb[p0 + lane] = bs; sg[p0 + lane] = g; sig[p0 + lane] = ig; }
        const float Bc = __shfl(bs, T - 1), gl = __shfl(g, T - 1);
        if (lane == 0) { sB[c] = Bc; sMl[c] = Bc + gl; }
    }
    __syncthreads();
    if (tid == 0) { float m = 0.f; sm0[0] = 0.f; for (int c = 0; c < 33; ++c) { m = fmaxf(m + sB[c], sMl[c]); sm0[c + 1] = m; } }
    __syncthreads();
    for (int p = tid; p < LP; p += NWAVES * 64) { const int c = p < NMETA ? 0 : ((p - NMETA) >> 6) + 1;
        F.SCB[(size_t)bh * LP + p] = sb[p]; F.SCM[(size_t)bh * LP + p] = sb[p] + fmaxf(sm0[c], sg[p]); F.WS[(size_t)bh * LP + p] = __expf(sB[c] - sb[p] + sig[p] - sm0[c + 1]); }
    if (tid < 34) F.M0[bh * 34 + tid] = sm0[tid];
    if (tid < 33) F.DEC[bh * 33 + tid] = __expf(sB[tid] + sm0[tid] - sm0[tid + 1]);
    __syncthreads();
}
constexpr int CK_STRIDE = 64, CV_STRIDE = 192, CK_BYTES = 64 * CK_STRIDE, CV_BYTES = 64 * CV_STRIDE, CBUF_BYTES = CK_BYTES + CV_BYTES;
__device__ __forceinline__ void s_chain(Frame& F, int unit) {
    const int bh = unit >> 3, ki = (unit >> 1) & 3, vh = unit & 1, b = bh >> 2, h = bh & 3, tid = F.tid, lane = F.lane, wave = F.wave;
    const bf16* Kp = F.P + 2 * P_STRIDE + h * HD + 32 * ki; const bf16* Vp = F.P + 3 * P_STRIDE + h * HD + 64 * vh;
    const float* WSp = F.WS + (size_t)bh * LP; const float* DECp = F.DEC + bh * 33;
    const int i16 = lane & 15, q4 = i16 >> 2, p4 = i16 & 3, blk = (lane >> 4) & 1, hh = lane >> 5, r32 = lane & 31;
    const bool cwave = wave < 2, nwave = (wave == 2) && (vh == 0);
    f32x16 acc;
#pragma unroll
    for (int i = 0; i < 16; ++i) acc[i] = 0.f;
    bf16x8 ones;
#pragma unroll
    for (int j = 0; j < 8; ++j) ones[j] = (r32 == 0) ? (short)0x3F80 : (short)0;
    const int vrow = tid >> 3, vcc = tid & 7, krow = (tid & 255) >> 2, kcc = tid & 3; const bool kthr = tid < 256;
    v4u vA, vB, kA, kB; float wA = 0.f, wB = 0.f;
    kA = (v4u){0u, 0u, 0u, 0u}; kB = kA;
#define C_LOAD(c_, vS, kS, wS) do { const int T_ = chunk_T(c_), row0_ = chunk_row0(b, c_), p0_ = chunk_p0(c_); vS = (v4u){0u, 0u, 0u, 0u}; \
        if (vrow < T_) vS = *(const v4u*)(Vp + (size_t)(row0_ + vrow) * 512 + vcc * 8); \
        if (kthr) { kS = (v4u){0u, 0u, 0u, 0u}; wS = 0.f; if (krow < T_) { kS = *(const v4u*)(Kp + (size_t)(row0_ + krow) * 512 + kcc * 8); wS = WSp[p0_ + krow]; } } } while (0)
#define C_WRITE(vS, kS, wS, d_) do { *(LAS v4u*)(F.lds + (d_) * CBUF_BYTES + CK_BYTES + vrow * CV_STRIDE + vcc * 16) = vS; \
        if (kthr) { v4u w = kS; w.x = cvtpk(bflo(w.x) * wS, bfhi(w.x) * wS); w.y = cvtpk(bflo(w.y) * wS, bfhi(w.y) * wS); w.z = cvtpk(bflo(w.z) * wS, bfhi(w.z) * wS); w.w = cvtpk(bflo(w.w) * wS, bfhi(w.w) * wS); \
            *(LAS v4u*)(F.lds + (d_) * CBUF_BYTES + krow * CK_STRIDE + kcc * 16) = w; } } while (0)
#define C_COMPUTE(c_) do { const int cc_ = (c_); if (cwave || nwave) { const float dec = DECp[cc_]; \
        if (cc_ >= 1) { if (cwave) { bf16* Cs = F.CST + ((size_t)(bh * 32 + (cc_ - 1)) * HD + 64 * vh + 32 * wave + r32) * HD + 32 * ki + 4 * hh; \
                _Pragma("unroll") for (int g = 0; g < 4; ++g) { v2u w0; w0.x = cvtpk(acc[4 * g], acc[4 * g + 1]); w0.y = cvtpk(acc[4 * g + 2], acc[4 * g + 3]); *(v2u*)(Cs + 8 * g) = w0; } } \
            else if (r32 == 0) { float* Ns = F.NST + (size_t)(bh * 32 + (cc_ - 1)) * HD + 32 * ki + 4 * hh; \
                _Pragma("unroll") for (int g = 0; g < 4; ++g) { f32x4 o; o.x = acc[4 * g]; o.y = acc[4 * g + 1]; o.z = acc[4 * g + 2]; o.w = acc[4 * g + 3]; *(f32x4*)(Ns + 8 * g) = o; } } } \
        const LAS unsigned char* kb = F.lds + (cc_ & 1) * CBUF_BYTES; const LAS unsigned char* vb = kb + CK_BYTES; \
        bf16x8 Af[4], Bf[4]; \
        _Pragma("unroll") for (int s = 0; s < 4; ++s) { const int rlo = 16 * s + 8 * hh + q4; \
            Af[s] = cat8(vtr(kb + rlo * CK_STRIDE + 2 * (16 * blk + 4 * p4)), vtr(kb + (rlo + 4) * CK_STRIDE + 2 * (16 * blk + 4 * p4))); \
            if (cwave) Bf[s] = cat8(vtr(vb + rlo * CV_STRIDE + 2 * (32 * wave + 16 * blk + 4 * p4)), vtr(vb + (rlo + 4) * CV_STRIDE + 2 * (32 * wave + 16 * blk + 4 * p4))); else Bf[s] = ones; } \
        _Pragma("unroll") for (int i = 0; i < 16; ++i) acc[i] *= dec; \
        _Pragma("unroll") for (int s = 0; s < 4; ++s) acc = MFMA32(Af[s], Bf[s], acc); } } while (0)
    C_LOAD(0, vA, kA, wA); C_WRITE(vA, kA, wA, 0); C_LOAD(1, vA, kA, wA);
    __syncthreads();
    for (int c = 0; c < 32; c += 2) {
        C_LOAD(c + 2, vB, kB, wB); C_COMPUTE(c); C_WRITE(vA, kA, wA, 1); __syncthreads();
        if (c + 3 < 33) C_LOAD(c + 3, vA, kA, wA);
        C_COMPUTE(c + 1); C_WRITE(vB, kB, wB, 0); __syncthreads();
    }
    C_COMPUTE(32);
#undef C_LOAD
#undef C_WRITE
#undef C_COMPUTE
    if (cwave) { float* Co = F.out + O_CP + (size_t)bh * HD * HD + 64 * vh + 32 * wave + r32;
#pragma unroll
        for (int i = 0; i < 16; ++i) Co[(size_t)(32 * ki + (i & 3) + 8 * (i >> 2) + 4 * hh) * HD] = acc[i]; }
    if (nwave && r32 == 0) {
#pragma unroll
        for (int i = 0; i < 16; ++i) F.out[O_NP + bh * HD + 32 * ki + (i & 3) + 8 * (i >> 2) + 4 * hh] = acc[i]; }
    if (unit == (bh << 3) && tid == 0) F.out[O_MP + bh] = F.M0[bh * 34 + 33];
    __syncthreads();
}

__device__ __forceinline__ void s_sample_pair(Frame& F, int pair) {
    const int lane = F.lane, wave = F.wave, w4 = wave & 3, task = 2 * pair + (wave >> 2);
    const int bs = task >> 2, h = task & 3, rowb = R_PROMPT + bs * DECT;
    LAS float* red = (LAS float*)F.lds + (wave >> 2) * (4 * 4 * HD);
    const float* Ci = F.state_C + (size_t)task * HD * HD; float* Co = F.out + O_CS + (size_t)task * HD * HD;
    f32x2 c2[32];
#pragma unroll
    for (int r = 0; r < 32; ++r) c2[r] = *(const f32x2*)(Ci + (size_t)(w4 * 32 + r) * HD + 2 * lane);
    float lf[4], ig[4], bt[4], mt[4];
    float q[4][2], k[4][2], vv[4][2], kw[4][2], n0[2];
    unsigned short qs_[4][2], ks_[4][2]; unsigned vw_[4];
#pragma unroll
    for (int t = 0; t < 4; ++t) {
        lf[t] = F.Gt[(size_t)(rowb + t) * 8 + 4 + h]; ig[t] = F.Gt[(size_t)(rowb + t) * 8 + h];
        const bf16* qr = F.P + 1 * P_STRIDE + (size_t)(rowb + t) * 512 + h * HD; const bf16* kr = F.P + 2 * P_STRIDE + (size_t)(rowb + t) * 512 + h * HD; const bf16* vr = F.P + 3 * P_STRIDE + (size_t)(rowb + t) * 512 + h * HD;
        qs_[t][0] = qr[lane]; qs_[t][1] = qr[lane + 64]; ks_[t][0] = kr[lane]; ks_[t][1] = kr[lane + 64]; vw_[t] = *(const unsigned*)(vr + 2 * lane);
    }
    const float m0 = F.state_m[task];
    n0[0] = F.state_n[task * HD + lane]; n0[1] = F.state_n[task * HD + lane + 64];
    const unsigned ow = *(const unsigned*)(F.P + 4 * P_STRIDE + (size_t)(rowb + w4) * 512 + h * HD + 2 * lane);
    { float mp = m0, ba = 0.f;
#pragma unroll
      for (int t = 0; t < 4; ++t) { ba += lf[t]; bt[t] = ba; mt[t] = fmaxf(lf[t] + mp, ig[t]); mp = mt[t]; } }
    const float ml = mt[3], dec = __expf(bt[3] + m0 - ml);
#pragma unroll
    for (int t = 0; t < 4; ++t) { q[t][0] = bf2f(qs_[t][0]); q[t][1] = bf2f(qs_[t][1]); k[t][0] = bf2f(ks_[t][0]); k[t][1] = bf2f(ks_[t][1]); vv[t][0] = bflo(vw_[t]); vv[t][1] = bfhi(vw_[t]);
        const float ws = __expf(bt[3] - bt[t] + ig[t] - ml); kw[t][0] = ws * k[t][0]; kw[t][1] = ws * k[t][1]; }
    float Pm[4][4], den[4], inter[4];
#pragma unroll
    for (int t = 0; t < 4; ++t) {
        inter[t] = __expf(bt[t] + m0 - mt[t]);
        float dsum = inter[t] * wave_sum(q[t][0] * n0[0] + q[t][1] * n0[1]);
#pragma unroll
        for (int s = 0; s < 4; ++s) { if (s <= t) { Pm[t][s] = wave_sum(q[t][0] * k[s][0] + q[t][1] * k[s][1]) * __expf(bt[t] - bt[s] + ig[s] - mt[t]); dsum += Pm[t][s]; } else Pm[t][s] = 0.f; }
        den[t] = fmaxf(fabsf(dsum), __expf(-mt[t]));
    }
    if (w4 == 0) { F.out[O_NS + task * HD + lane] = dec * n0[0] + (kw[0][0] + kw[1][0]) + (kw[2][0] + kw[3][0]); F.out[O_NS + task * HD + lane + 64] = dec * n0[1] + (kw[0][1] + kw[1][1]) + (kw[2][1] + kw[3][1]);
        if (lane == 0) F.out[O_MS + task] = ml; }
    float np[4][2];
#pragma unroll
    for (int t = 0; t < 4; ++t) { np[t][0] = 0.f; np[t][1] = 0.f; }
    LAS float* tab = (LAS float*)F.lds + 8192 + wave * 1024;
    { f32x4 x; x.x = q[0][0]; x.y = q[1][0]; x.z = q[2][0]; x.w = q[3][0]; *(LAS f32x4*)(tab + 8 * lane) = x; x.x = kw[0][0]; x.y = kw[1][0]; x.z = kw[2][0]; x.w = kw[3][0]; *(LAS f32x4*)(tab + 8 * lane + 4) = x;
      x.x = q[0][1]; x.y = q[1][1]; x.z = q[2][1]; x.w = q[3][1]; *(LAS f32x4*)(tab + 8 * (lane + 64)) = x; x.x = kw[0][1]; x.y = kw[1][1]; x.z = kw[2][1]; x.w = kw[3][1]; *(LAS f32x4*)(tab + 8 * (lane + 64) + 4) = x; }
    LDS_WAIT(); asm volatile("" ::: "memory");
#pragma unroll
    for (int r = 0; r < 32; ++r) {
        const f32x4 qs = *(const LAS f32x4*)(tab + 8 * (w4 * 32 + r)), ks = *(const LAS f32x4*)(tab + 8 * (w4 * 32 + r) + 4);
        float o0 = dec * c2[r].x, o1 = dec * c2[r].y;
#pragma unroll
        for (int t = 0; t < 4; ++t) { o0 += ks[t] * vv[t][0]; o1 += ks[t] * vv[t][1]; np[t][0] += qs[t] * c2[r].x; np[t][1] += qs[t] * c2[r].y; }
        f32x2 o; o.x = o0; o.y = o1; *(f32x2*)(Co + (size_t)(w4 * 32 + r) * HD + 2 * lane) = o;
    }
#pragma unroll
    for (int t = 0; t < 4; ++t) { f32x2 o; o.x = np[t][0]; o.y = np[t][1]; *(LAS f32x2*)(red + (w4 * 4 + t) * HD + 2 * lane) = o; }
    __syncthreads();
#pragma unroll
    for (int t = 0; t < 4; ++t) if (w4 == t) {
        float a0 = 0.f, a1 = 0.f;
#pragma unroll
        for (int w = 0; w < 4; ++w) { const f32x2 x = *(const LAS f32x2*)(red + (w * 4 + t) * HD + 2 * lane); a0 += x.x; a1 += x.y; }
        a0 *= inter[t]; a1 *= inter[t];
#pragma unroll
        for (int s = 0; s < 4; ++s) if (s <= t) { a0 += Pm[t][s] * vv[s][0]; a1 += Pm[t][s] * vv[s][1]; }
        const float h0 = a0 / den[t], h1 = a1 / den[t];
        const float rn = 1.f / sqrtf(wave_sum(h0 * h0 + h1 * h1) * (1.f / HD) + EPS);
        *(unsigned*)(F.MIX + (size_t)(rowb + t) * D + PW + h * HD + 2 * lane) = pk2(h0 * rn * sigmoidf_(bflo(ow)), h1 * rn * sigmoidf_(bfhi(ow)));
    }
    __syncthreads();
}
__device__ __forceinline__ void p2_state(Frame& F) {
    for (int u = (int)blockIdx.x; u < NB * NH * 8; u += F.G) s_chain(F, u);
    for (int pair = (int)blockIdx.x; pair < DECB * NH / 2; pair += F.G) s_sample_pair(F, pair);
}

#define SCHED_FENCE() __builtin_amdgcn_sched_barrier(0)
__device__ __forceinline__ void mlstm_out_unit(Frame& F, int u) {
    const int lane = F.lane, wave = F.wave, tid = F.tid;
    const int i16 = lane & 15, q4 = i16 >> 2, p4 = i16 & 3, blk = (lane >> 4) & 1, hh = lane >> 5, r32 = lane & 31;
    const int b = u >> 5, c = (u & 31) + 1, row0 = b * SEQ + (c - 1) * 64, p0 = NMETA + (c - 1) * 64;
    LAS float* sa = (LAS float*)(F.lds + 4 * IMG_BYTES);
    const int h = wave >> 1, th = wave & 1, bh = b * 4 + h;
    const int t = 32 * th + r32, row = row0 + t;
    v4u vw[8];
#pragma unroll
    for (int i = 0; i < 8; ++i) { const int id = tid + 512 * i, vr = id >> 6, cc = id & 63; vw[i] = *(const v4u*)(F.P + 3 * P_STRIDE + (size_t)(row0 + vr) * 512 + cc * 8); }
    float av = 0.f;
    if (tid < 256) { const int hd = tid >> 6, s = tid & 63; av = F.Gt[(size_t)(row0 + s) * 8 + hd] - F.SCB[(size_t)((b * 4 + hd)) * LP + p0 + s]; }
    const float bt = F.SCB[(size_t)bh * LP + p0 + t], mt = F.SCM[(size_t)bh * LP + p0 + t], m0c = F.M0[bh * 34 + c];
    bf16x8 qf[8];
#pragma unroll
    for (int s = 0; s < 8; ++s) qf[s] = *(const bf16x8*)(F.P + 1 * P_STRIDE + (size_t)row * 512 + h * HD + 16 * s + 8 * hh);
    f32x4 n0v[16];
    { const float* Ns = F.NST + (size_t)(bh * 32 + (c - 1)) * HD + 8 * hh;
#pragma unroll
      for (int s = 0; s < 8; ++s) { n0v[2 * s] = *(const f32x4*)(Ns + 16 * s); n0v[2 * s + 1] = *(const f32x4*)(Ns + 16 * s + 4); } }
    const bf16* Cs = F.CST + ((size_t)(bh * 32 + (c - 1)) * HD) * HD + (size_t)r32 * HD + 8 * hh;
    bf16x8 A0[8], A1[8];
#pragma unroll
    for (int s = 0; s < 8; ++s) A0[s] = *(const bf16x8*)(Cs + (size_t)(0 * 32) * HD + 16 * s);
    SCHED_FENCE();
#pragma unroll
    for (int i = 0; i < 8; ++i) { const int id = tid + 512 * i, vr = id >> 6, cc = id & 63; *(LAS v4u*)(F.lds + (cc >> 4) * IMG_BYTES + vr * IMG_STRIDE + (cc & 15) * 16) = vw[i]; }
    if (tid < 256) sa[tid] = av;
    SCHED_FENCE();
#pragma unroll
    for (int s = 0; s < 8; ++s) A1[s] = *(const bf16x8*)(Cs + (size_t)(1 * 32) * HD + 16 * s);
    __syncthreads();
    const float ct = bt - mt, inter = __expf(bt + m0c - mt), emt = __expf(-mt);
    float qn = 0.f;
#pragma unroll
    for (int s = 0; s < 8; ++s) { const f32x4 n0a = n0v[2 * s], n0b = n0v[2 * s + 1]; const v4u qw = __builtin_bit_cast(v4u, qf[s]);
        qn += (bflo(qw.x) * n0a.x + bfhi(qw.x) * n0a.y) + (bflo(qw.y) * n0a.z + bfhi(qw.y) * n0a.w) + (bflo(qw.z) * n0b.x + bfhi(qw.z) * n0b.y) + (bflo(qw.w) * n0b.z + bfhi(qw.w) * n0b.w); }
    qn += __shfl_xor(qn, 32);
    SCHED_FENCE();
    f32x16 OT[4];
#pragma unroll
    for (int vt = 0; vt < 4; ++vt)
#pragma unroll
        for (int i = 0; i < 16; ++i) OT[vt][i] = 0.f;
#pragma unroll
    for (int s = 0; s < 8; ++s) OT[0] = MFMA32(A0[s], qf[s], OT[0]);
    SCHED_FENCE();
#pragma unroll
    for (int s = 0; s < 8; ++s) A0[s] = *(const bf16x8*)(Cs + (size_t)(2 * 32) * HD + 16 * s);
    SCHED_FENCE();
#pragma unroll
    for (int s = 0; s < 8; ++s) OT[1] = MFMA32(A1[s], qf[s], OT[1]);
    SCHED_FENCE();
#pragma unroll
    for (int s = 0; s < 8; ++s) A1[s] = *(const bf16x8*)(Cs + (size_t)(3 * 32) * HD + 16 * s);
    SCHED_FENCE();
#pragma unroll
    for (int s = 0; s < 8; ++s) OT[2] = MFMA32(A0[s], qf[s], OT[2]);
    SCHED_FENCE();
    const bf16* Kr = F.P + 2 * P_STRIDE + (size_t)(row0 + r32) * 512 + h * HD + 8 * hh;
#pragma unroll
    for (int s = 0; s < 8; ++s) A0[s] = *(const bf16x8*)(Kr + 16 * s);
    SCHED_FENCE();
#pragma unroll
    for (int s = 0; s < 8; ++s) OT[3] = MFMA32(A1[s], qf[s], OT[3]);
    SCHED_FENCE();
    if (th) {
#pragma unroll
        for (int s = 0; s < 8; ++s) A1[s] = *(const bf16x8*)(Kr + (size_t)32 * 512 + 16 * s);
    }
    SCHED_FENCE();
#pragma unroll
    for (int vt = 0; vt < 4; ++vt)
#pragma unroll
        for (int i = 0; i < 16; ++i) OT[vt][i] *= inter;
    float csum = 0.f;
    const LAS unsigned char* vimg = F.lds + h * IMG_BYTES;
#pragma unroll
    for (int stile = 0; stile < 2; ++stile) if (stile <= th) {
        f32x16 ST;
#pragma unroll
        for (int i = 0; i < 16; ++i) ST[i] = 0.f;
        if (stile == 0) {
#pragma unroll
            for (int s = 0; s < 8; ++s) ST = MFMA32(A0[s], qf[s], ST);
        } else {
#pragma unroll
            for (int s = 0; s < 8; ++s) ST = MFMA32(A1[s], qf[s], ST);
        }
        const float pen = (stile == th) ? 1e30f : 0.f, tl = (float)(r32 - 4 * hh);
#pragma unroll
        for (int g = 0; g < 4; ++g) { const f32x4 as4 = *(const LAS f32x4*)(sa + h * 64 + 32 * stile + 8 * g + 4 * hh);
#pragma unroll
            for (int e = 0; e < 4; ++e) { const float dv = __expf(fminf(tl - (float)(8 * g + e), 0.f) * pen + (ct + as4[e])); const float pv = ST[4 * g + e] * dv; ST[4 * g + e] = pv; csum += pv; } }
#pragma unroll
        for (int ks = 0; ks < 2; ++ks) {
            v4u pw; pw.x = cvtpk(ST[8 * ks], ST[8 * ks + 1]); pw.y = cvtpk(ST[8 * ks + 2], ST[8 * ks + 3]); pw.z = cvtpk(ST[8 * ks + 4], ST[8 * ks + 5]); pw.w = cvtpk(ST[8 * ks + 6], ST[8 * ks + 7]);
            const bf16x8 Pf = __builtin_bit_cast(bf16x8, pw);
            const int rlo = 32 * stile + 16 * ks + 4 * hh + q4;
            bf16x8 Vf[4];
#pragma unroll
            for (int vt = 0; vt < 4; ++vt) Vf[vt] = cat8(vtr(vimg + rlo * IMG_STRIDE + 2 * (32 * vt + 16 * blk + 4 * p4)), vtr(vimg + (rlo + 8) * IMG_STRIDE + 2 * (32 * vt + 16 * blk + 4 * p4)));
#pragma unroll
            for (int vt = 0; vt < 4; ++vt) OT[vt] = MFMA32(Vf[vt], Pf, OT[vt]);
        }
    }
    v2u ow[16];
#pragma unroll
    for (int vt = 0; vt < 4; ++vt)
#pragma unroll
        for (int g = 0; g < 4; ++g) ow[4 * vt + g] = *(const v2u*)(F.P + 4 * P_STRIDE + (size_t)row * 512 + h * HD + 32 * vt + 8 * g + 4 * hh);
    SCHED_FENCE();
    csum += __shfl_xor(csum, 32);
    const float den = fmaxf(fabsf(inter * qn + csum), emt), rden = 1.f / den;
    float ss = 0.f;
#pragma unroll
    for (int vt = 0; vt < 4; ++vt)
#pragma unroll
        for (int i = 0; i < 16; ++i) { OT[vt][i] *= rden; ss += OT[vt][i] * OT[vt][i]; }
    ss += __shfl_xor(ss, 32);
    const float rn = 1.f / sqrtf(ss * (1.f / HD) + EPS);
#pragma unroll
    for (int vt = 0; vt < 4; ++vt)
#pragma unroll
        for (int g = 0; g < 4; ++g) { const int v0 = 32 * vt + 8 * g + 4 * hh; const v2u o2 = ow[4 * vt + g];
            v2u w; w.x = cvtpk(OT[vt][4 * g] * rn * sigmoidf_(bflo(o2.x)), OT[vt][4 * g + 1] * rn * sigmoidf_(bfhi(o2.x)));
            w.y = cvtpk(OT[vt][4 * g + 2] * rn * sigmoidf_(bflo(o2.y)), OT[vt][4 * g + 3] * rn * sigmoidf_(bfhi(o2.y)));
            *(v2u*)(F.MIX + (size_t)row * D + PW + h * HD + v0) = w; }
    __syncthreads();
}

template <int NT> __device__ __forceinline__ void pool_tokens(const v4u (&rw)[15 + NT], int g, bf16* dst  ) {
    const float invw = g == 0 ? 0.5f : g == 1 ? 0.25f : g == 2 ? 0.125f : 0.0625f, m4 = g >= 1 ? 1.f : 0.f, m8 = g >= 2 ? 1.f : 0.f, m16 = g >= 3 ? 1.f : 0.f;
    unsigned ow[NT][4];
#pragma unroll
    for (int k = 0; k < 4; ++k) {
        float lo[15 + NT], hi[15 + NT];
#pragma unroll
        for (int i = 0; i < 15 + NT; ++i) { const unsigned w = rw[i][k]; lo[i] = bflo(w); hi[i] = bfhi(w); }
#pragma unroll
        for (int t = 0; t < NT; ++t) { const int i = 15 + t;
            const float a2 = lo[i] + lo[i - 1], a4 = lo[i - 2] + lo[i - 3], a8 = (lo[i - 4] + lo[i - 5]) + (lo[i - 6] + lo[i - 7]);
            const float a16 = ((lo[i - 8] + lo[i - 9]) + (lo[i - 10] + lo[i - 11])) + ((lo[i - 12] + lo[i - 13]) + (lo[i - 14] + lo[i - 15]));
            const float b2 = hi[i] + hi[i - 1], b4 = hi[i - 2] + hi[i - 3], b8 = (hi[i - 4] + hi[i - 5]) + (hi[i - 6] + hi[i - 7]);
            const float b16 = ((hi[i - 8] + hi[i - 9]) + (hi[i - 10] + hi[i - 11])) + ((hi[i - 12] + hi[i - 13]) + (hi[i - 14] + hi[i - 15]));
            const float pa = (a2 + m4 * a4 + m8 * a8 + m16 * a16) * invw - lo[i];
            const float pb = (b2 + m4 * b4 + m8 * b8 + m16 * b16) * invw - hi[i];
            ow[t][k] = cvtpk(pa, pb); }
    }
#pragma unroll
    for (int t = 0; t < NT; ++t) { v4u w; w.x = ow[t][0]; w.y = ow[t][1]; w.z = ow[t][2]; w.w = ow[t][3]; *(v4u*)(dst + (size_t)t * D) = w; }
}
__device__ __forceinline__ void pool_unit(Frame& F, int u) {
    const int lane = F.lane, wave = F.wave;
    const bf16* U = F.P;
    const int g_l = lane >> 4;
    if (u < NB * 32) {
        const int b = u >> 5, tr0 = (u & 31) * 64;
        v4u rw[23];
#pragma unroll
        for (int i = 0; i < 23; ++i) { const int tr = tr0 + 8 * wave - 15 + i; const int r = tr >= 0 ? b * SEQ + tr : R_META0 + NMETA + tr; rw[i] = *(const v4u*)(U + (size_t)r * 512 + 8 * lane); }
        pool_tokens<8>(rw, g_l, F.MIX + (size_t)(b * SEQ + tr0 + 8 * wave) * D + 8 * lane);
    } else {
        const int su = u - NB * 32;
#pragma unroll
        for (int sq = 0; sq < 2; ++sq) { const int seq = su * 16 + 2 * wave + sq;
            v4u rw[19];
#pragma unroll
            for (int i = 0; i < 15; ++i) { const float* cr = F.state_pool + ((size_t)seq * 15 + i) * 512 + 8 * lane; const f32x4 x0 = *(const f32x4*)cr, x1 = *(const f32x4*)(cr + 4);
                rw[i].x = cvtpk(x0.x, x0.y); rw[i].y = cvtpk(x0.z, x0.w); rw[i].z = cvtpk(x1.x, x1.y); rw[i].w = cvtpk(x1.z, x1.w); }
#pragma unroll
            for (int i = 0; i < 4; ++i) rw[15 + i] = *(const v4u*)(U + (size_t)(R_PROMPT + seq * DECT + i) * 512 + 8 * lane);
            pool_tokens<4>(rw, g_l, F.MIX + (size_t)(R_PROMPT + seq * DECT) * D + 8 * lane); }
    }
}
__device__ __forceinline__ void p3_out(Frame& F) {
    for (int u = (int)blockIdx.x; u < NB * 32; u += F.G) mlstm_out_unit(F, u);
    for (int u = (int)blockIdx.x; u < NB * 32 + R_SAMPLE / 64; u += F.G) pool_unit(F, u);
}

__device__ __forceinline__ void fold_pool_tile(Frame& F, int id) {
    const int g = id >> 7, n0 = 32 * ((id >> 2) & 31), c0 = 32 * (id & 3), lane = F.lane, r32 = lane & 31, hh = lane >> 5;
    f32x16 acc;
#pragma unroll
    for (int i = 0; i < 16; ++i) acc[i] = 0.f;
    bf16x8 A[8]; f32x4 wa[8], wb[8], sa_[8], sb_[8];
#pragma unroll
    for (int s = 0; s < 8; ++s) { A[s] = *(const bf16x8*)(F.WoRaw + (size_t)(n0 + r32) * PW + g * 128 + 16 * s + 8 * hh);
        const float* wp = F.w_pool + (size_t)g * 16384 + (size_t)(c0 + r32) * 128 + 16 * s + 8 * hh; const float* sc = F.pool_scale + g * 128 + 16 * s + 8 * hh;
        wa[s] = *(const f32x4*)wp; wb[s] = *(const f32x4*)(wp + 4); sa_[s] = *(const f32x4*)sc; sb_[s] = *(const f32x4*)(sc + 4); }
#pragma unroll
    for (int s = 0; s < 8; ++s) { const f32x4 x = wa[s] * sa_[s], y = wb[s] * sb_[s]; v4u w; w.x = cvtpk(x.x, x.y); w.y = cvtpk(x.z, x.w); w.z = cvtpk(y.x, y.y); w.w = cvtpk(y.z, y.w);
        acc = MFMA32(A[s], __builtin_bit_cast(bf16x8, w), acc); }
#pragma unroll
    for (int i = 0; i < 16; ++i) { const int n = n0 + (i & 3) + 8 * (i >> 2) + 4 * hh; F.Wout_t[(size_t)n * D + g * 128 + c0 + r32] = (bf16)f2bf(acc[i]); }
}

__device__ __forceinline__ void p3_poolstate(Frame& F) {
    const int gt = blockIdx.x * (NWAVES * 64) + F.tid, ngt = F.G * NWAVES * 64;
    for (int e = gt; e < NB * 15 * 512; e += ngt) { const int c = e & 511, i = (e >> 9) % 15, b = e / (15 * 512); F.out[O_POOLP + e] = bf2f(F.P[(size_t)(b * SEQ + SEQ - 15 + i) * 512 + c]); }
    for (int e = gt; e < DECB * 15 * 512; e += ngt) { const int c = e & 511, i = (e >> 9) % 15, b = e / (15 * 512);
        F.out[O_POOLS + e] = (i < 11) ? F.state_pool[((size_t)b * 15 + i + 4) * 512 + c] : bf2f(F.P[(size_t)(R_PROMPT + b * DECT + (i - 11)) * 512 + c]); }
}

__device__ __forceinline__ void p5_norm2(Frame& F) {
    for (int m = F.gw; m < R_MAIN; m += F.NGW) { f32x4 xn[4]; rms_row_to_bf16(F.out + O_Y + (size_t)m * D, F.norm2, F.XN + (size_t)m * D, F.lane, xn); }
}
__device__ __forceinline__ void p8_final(Frame& F) {
    for (int m = F.gw; m < R_MAIN; m += F.NGW) {
        GAS f32x4* xr = (GAS f32x4*)(F.out + O_Y + (size_t)m * D) + F.lane; const GAS f32x4* gr = (const GAS f32x4*)F.norm_f + F.lane;
        f32x4 v[4]; float s = 0.f;
#pragma unroll
        for (int j = 0; j < 4; ++j) { v[j] = xr[64 * j]; s += (v[j].x * v[j].x + v[j].y * v[j].y) + (v[j].z * v[j].z + v[j].w * v[j].w); }
        const float r = 1.f / sqrtf(wave_sum(s) * (1.f / D) + EPS);
#pragma unroll
        for (int j = 0; j < 4; ++j) xr[64 * j] = v[j] * r * gr[64 * j];
    }
}

struct Args { const float* in[18]; float* out; unsigned char* ws; int ph_lo, ph_hi; };
__global__ void __launch_bounds__(NWAVES * 64, 2) fwd_kernel(Args args) {
    extern __shared__ __attribute__((aligned(16))) unsigned char lds[];
    Frame F;
    F.lds = (LAS unsigned char*)lds;
    F.tid = threadIdx.x; F.lane = F.tid & 63; F.wave = __builtin_amdgcn_readfirstlane(F.tid >> 6);
    F.G = gridDim.x; F.gw = blockIdx.x * NWAVES + F.wave; F.NGW = F.G * NWAVES;
    F.x_prompt = args.in[0]; F.x_sample = args.in[1]; F.state_pool = args.in[2]; F.state_C = args.in[3]; F.state_n = args.in[4]; F.state_m = args.in[5]; F.meta = args.in[6]; F.norm1 = args.in[7];
    F.w_in = args.in[8]; F.b_gate = args.in[9]; F.w_pool = args.in[10]; F.pool_scale = args.in[11]; F.head_gain = args.in[12]; F.w_out = args.in[13]; F.norm2 = args.in[14]; F.w_up = args.in[15];
    F.w_down = args.in[16]; F.norm_f = args.in[17]; F.out = args.out;
    unsigned char* ws = args.ws;
    F.Win_t = (bf16*)(ws + WS_WIN); F.Wout_t = (bf16*)(ws + WS_WOUT); F.Wup_t = (bf16*)(ws + WS_WUP); F.Wdn_t = (bf16*)(ws + WS_WDN);
    F.Gt = (float*)(ws + WS_G); F.XN = (bf16*)(ws + WS_XN); F.P = (bf16*)(ws + WS_P); F.MIX = (bf16*)(ws + WS_MIX); F.CST = (bf16*)(ws + WS_CST); F.WoRaw = (bf16*)(ws + WS_WORAW); F.NST = (float*)(ws + WS_NST); F.SCB = (float*)(ws + WS_SCB); F.SCM = (float*)(ws + WS_SCM); F.M0 = (float*)(ws + WS_M0); F.WS = (float*)(ws + WS_WSA); F.DEC = (float*)(ws + WS_DEC); F.H = (bf16*)(ws + WS_H);
    for (int u = F.tid; u < (LDS_BYTES - RING_BYTES) / 4; u += NWAVES * 64) ((LAS unsigned*)(F.lds + RING_BYTES))[u] = 0u;
    __syncthreads();
    XcdBarrier bar = xcd_barrier_post((unsigned*)(ws + WS_CTL) + CW_BAR, (volatile LAS unsigned*)(F.lds + MISC_OFF) + 8);
    const int lo = args.ph_lo, hi = args.ph_hi;
#define IN(k) (lo <= (k) && (k) < hi)
#define GRID_BAR() xcd_barrier(bar)
    if (IN(0)) { p0_prologue(F); }
    if (IN(0) && IN(1)) GRID_BAR();
    if (IN(1)) { pg8::Gemm g{F.XN, F.Win_t, M_IN, NIN, D}; pg8::StaticOrder S; S.init(M_IN, NIN, F.G, (int)blockIdx.x);
        pg8::EpiIn E{F.P, P_STRIDE, 0.08838834764831845f};
        pg8::gemm_phase<pg8::EpiIn, pg8::StaticOrder, PG8_ALIGN, PG8_SP2>(F.lds, g, S, E);
        { const int first_idle = ((M_IN / 256) * (NIN / 256)) % F.G, nidle = first_idle ? F.G - first_idle : F.G, rank = first_idle ? (int)blockIdx.x - first_idle : (int)blockIdx.x;
          if (rank >= 0) { for (int bh = rank; bh < NB * NH; bh += nidle) s_scan(F, bh);
              for (int id = rank * NWAVES + F.wave; id < 512; id += nidle * NWAVES) fold_pool_tile(F, id); } } }
    if (IN(1) && IN(2)) GRID_BAR();
    if (IN(2)) { p2_state(F); }
    if (IN(2) && IN(3)) GRID_BAR();
    if (IN(3)) { p3_out(F); p3_poolstate(F); }
    if (IN(3) && IN(4)) GRID_BAR();
    if (IN(4)) { pg8::Gemm g{F.MIX, F.Wout_t, R_MAIN, D, D}; pg8::StaticOrder S; S.init(R_MAIN, D, F.G, (int)blockIdx.x);
        pg8::EpiRes E{F.x_prompt, F.x_sample, R_PROMPT / 256, F.out + O_Y};
        pg8::gemm_phase<pg8::EpiRes, pg8::StaticOrder, PG8_ALIGN, PG8_SP2>(F.lds, g, S, E); }
    if (IN(4) && IN(5)) GRID_BAR();
    if (IN(5)) { p5_norm2(F); }
    if (IN(5) && IN(6)) GRID_BAR();
    if (IN(6)) { pg8::Gemm g{F.XN, F.Wup_t, R_MAIN, FF, D}; pg8::StaticOrder S; S.init(R_MAIN, FF, F.G, (int)blockIdx.x);
        pg8::EpiRelu2 E{F.H, FF};
        pg8::gemm_phase<pg8::EpiRelu2, pg8::StaticOrder, PG8_ALIGN, PG8_SP2>(F.lds, g, S, E); }
    if (IN(6) && IN(7)) GRID_BAR();
    if (IN(7)) { pg8::Gemm g{F.H, F.Wdn_t, R_MAIN, D, FF}; pg8::StaticOrder S; S.init(R_MAIN, D, F.G, (int)blockIdx.x);
        pg8::EpiRes E{F.out + O_Y, F.out + O_Y, 1 << 20, F.out + O_Y};
        pg8::gemm_phase<pg8::EpiRes, pg8::StaticOrder, PG8_ALIGN, PG8_SP2>(F.lds, g, S, E); }
    if (IN(7) && IN(8)) GRID_BAR();
    if (IN(8)) { p8_final(F); }
#undef IN
#undef GRID_BAR
}

extern "C" void kernel_launch(void* const* d_in, const int* in_sizes, int n_in, void* d_out, int out_size, void* d_ws, size_t ws_size, hipStream_t stream) {
    static int grid = 0;
    if (grid == 0) {
        if (n_in != 18 || out_size != (int)O_END || ws_size < WS_END) { fprintf(stderr, "kernel_launch: unexpected shapes n_in %d out %d ws %zu\n", n_in, out_size, ws_size); grid = -1; return; }
        int dev = 0, cus = 0;
        if (hipGetDevice(&dev) != hipSuccess || hipDeviceGetAttribute(&cus, hipDeviceAttributeMultiprocessorCount, dev) != hipSuccess) { grid = -1; return; }
        if (hipFuncSetAttribute((const void*)fwd_kernel, hipFuncAttributeMaxDynamicSharedMemorySize, LDS_BYTES) != hipSuccess) { fprintf(stderr, "kernel_launch: hipFuncSetAttribute failed\n"); grid = -1; return; }
        grid = cus;
    }
    if (grid < 0) return;
    Args a{};
    for (int i = 0; i < 18; ++i) a.in[i] = (const float*)d_in[i];
    a.out = (float*)d_out; a.ws = (unsigned char*)d_ws;
    if (hipMemsetAsync((char*)d_ws + WS_CTL, 0, CTL_ZERO_BYTES, stream) != hipSuccess) { fprintf(stderr, "kernel_launch: memset failed\n"); return; }
    a.ph_lo = 0; a.ph_hi = 9; hipLaunchKernelGGL(fwd_kernel, dim3(grid), dim3(NWAVES * 64), LDS_BYTES, stream, a);
}
```

```cpp
#include <hip/hip_runtime.h>
#include <cstdio>
#include <cstdint>
namespace pg8 {
#define PG8_LAS __attribute__((address_space(3)))
typedef unsigned short bf16_t;
typedef short bf16x8 __attribute__((ext_vector_type(8)));
typedef float f32x4 __attribute__((ext_vector_type(4)));
typedef unsigned u32x4 __attribute__((ext_vector_type(4)));
constexpr int BM = 256, BK = 64, HALF = 128, HTB = HALF * BK * 2  , STAGE_BYTES = 8 * HTB, NXCD = 8, WGM = 8;

__host__ __device__ __forceinline__ int lds_byte(int r, int c) { const int st = (r >> 4) * 2 + (c >> 5), rr = r & 15, cc = c & 31, ob = rr * 64 + cc * 2; return st * 1024 + (ob ^ (((ob >> 9) & 1) << 5)); }
__host__ __device__ __forceinline__ void stage_rc(int b, int& R, int& C) { const int st = b / 1024, sb = b % 1024, swz = sb ^ (((sb >> 9) & 1) << 5); R = (st >> 1) * 16 + swz / 64; C = (st & 1) * 32 + (swz % 64) / 2; }
__host__ __device__ __forceinline__ int perm32(int rho) { const int n = rho >> 4, i = rho & 15; return 8 * (i >> 2) + 4 * n + (i & 3); }

struct Unit { int pm, pn; };
struct Gemm { const bf16_t* A; const bf16_t* Bt; int M, N, K; };

struct StaticOrder {
    int nM, nN, nwg, G, c;
    __host__ __device__ void init(int M, int N, int G_, int c_) { nM = M / BM; nN = N / BM; nwg = nM * nN; G = G_; c = c_; }
    __host__ __device__ bool next(int i, Unit& u) const {
        const long L = (long)i * G + c; if (L >= nwg) return false;
        int wgid = (int)L; { const int q = nwg / NXCD, r = nwg % NXCD, xcd = wgid % NXCD, off = wgid / NXCD; wgid = (xcd < r ? xcd * (q + 1) : r * (q + 1) + (xcd - r) * q) + off; }
        const int nig = WGM * nN, gid = wgid / nig, fm = gid * WGM, gsz = (nM - fm) < WGM ? (nM - fm) : WGM;
        u.pm = fm + ((wgid % nig) % gsz); u.pn = (wgid % nig) / gsz; return true;
    }
    __device__ __forceinline__ void a_ready(const Unit&) const {}
    __device__ __forceinline__ void done(const Unit&) const {}
};

__device__ __forceinline__ unsigned cvt_pk_bf16(float lo, float hi) { unsigned r; asm volatile("v_cvt_pk_bf16_f32 %0, %1, %2" : "=v"(r) : "v"(lo), "v"(hi)); return r; }

struct EpiIn {
    static constexpr bool PERM = true, AFTER_DRAIN = false;
    bf16_t* O; size_t split_stride; float qscale;
    __device__ __forceinline__ void operator()(const f32x4 (&acc)[2][2][4][2], const Unit& u, int wr, int wc, int fr, int fq) const {
        const int row0 = u.pm * BM + wr * 64 + fr; const int t = u.pn >> 1; const int colt = (u.pn & 1) * BM;
        bf16_t* base = O + (size_t)t * split_stride; const float sc = (t == 1) ? qscale : 1.f;
        const int col0 = colt + wc * 32 + 8 * fq;
#pragma unroll
        for (int ai = 0; ai < 2; ++ai)
#pragma unroll
            for (int m = 0; m < 4; ++m) { bf16_t* rowp = base + (size_t)(row0 + ai * HALF + m * 16) * 512 + col0;
#pragma unroll
                for (int bj = 0; bj < 2; ++bj) { f32x4 v0 = acc[ai][bj][m][0] * sc, v1 = acc[ai][bj][m][1] * sc;
                    u32x4 w; w.x = cvt_pk_bf16(v0[0], v0[1]); w.y = cvt_pk_bf16(v0[2], v0[3]); w.z = cvt_pk_bf16(v1[0], v1[1]); w.w = cvt_pk_bf16(v1[2], v1[3]);
                    *(u32x4*)(rowp + bj * HALF) = w; } }
    }
};
struct EpiRelu2 {
    static constexpr bool PERM = true, AFTER_DRAIN = false;
    bf16_t* O; int ldc;
    __device__ __forceinline__ void operator()(const f32x4 (&acc)[2][2][4][2], const Unit& u, int wr, int wc, int fr, int fq) const {
        const int row0 = u.pm * BM + wr * 64 + fr; const int col0 = u.pn * BM + wc * 32 + 8 * fq;
#pragma unroll
        for (int ai = 0; ai < 2; ++ai)
#pragma unroll
            for (int m = 0; m < 4; ++m) { bf16_t* rowp = O + (size_t)(row0 + ai * HALF + m * 16) * ldc + col0;
#pragma unroll
                for (int bj = 0; bj < 2; ++bj) { f32x4 v0 = acc[ai][bj][m][0], v1 = acc[ai][bj][m][1];
#pragma unroll
                    for (int e = 0; e < 4; ++e) { const float a = fmaxf(v0[e], 0.f), b = fmaxf(v1[e], 0.f); v0[e] = a * a; v1[e] = b * b; }
                    u32x4 w; w.x = cvt_pk_bf16(v0[0], v0[1]); w.y = cvt_pk_bf16(v0[2], v0[3]); w.z = cvt_pk_bf16(v1[0], v1[1]); w.w = cvt_pk_bf16(v1[2], v1[3]);
                    *(u32x4*)(rowp + bj * HALF) = w; } }
    }
};
struct EpiRes {
    static constexpr bool PERM = false, AFTER_DRAIN = false;
    const float* resA; const float* resB; int split_pm; float* out;
    __device__ __forceinline__ void operator()(const f32x4 (&acc)[2][2][4][2], const Unit& u, int wr, int wc, int fr, int fq) const {
        const int row0 = u.pm * BM + wr * 64 + fr, col0 = u.pn * BM + wc * 32 + 4 * fq;
        const float* res = (u.pm < split_pm) ? resA : (resB - (size_t)split_pm * BM * 1024);
#pragma unroll
        for (int ai = 0; ai < 2; ++ai)
#pragma unroll
            for (int m = 0; m < 4; ++m) { const size_t off = (size_t)(row0 + ai * HALF + m * 16) * 1024 + col0;
#pragma unroll
                for (int bj = 0; bj < 2; ++bj)
#pragma unroll
                    for (int n = 0; n < 2; ++n) { const f32x4 r = *(const f32x4*)(res + off + bj * HALF + n * 16); *(f32x4*)(out + off + bj * HALF + n * 16) = r + acc[ai][bj][m][n]; } }
    }
};

template <class Epi, class Sched, bool ALIGN_EPI = false, bool SP2 = false>
__device__ __forceinline__ void gemm_phase(PG8_LAS unsigned char* lds, const Gemm g, const Sched& S, const Epi& E) {
    const int tid = threadIdx.x, wid = __builtin_amdgcn_readfirstlane(tid >> 6), lane = tid & 63, wr = wid >> 2, wc = wid & 3, fr = lane & 15, fq = lane >> 4;
    const int K = g.K, nt = K / BK;
    unsigned voffA[2], voffB[2];
#pragma unroll
    for (int i = 0; i < 2; ++i) { int R, C; stage_rc(tid * 16 + i * 8192, R, C); const int Rb = Epi::PERM ? ((R & ~31) + perm32(R & 31)) : R;
        voffA[i] = (unsigned)(R * K + C) * 2u; voffB[i] = (unsigned)(Rb * K + C) * 2u; }
    const size_t kstep = (size_t)(BK * 2);
    const size_t hstep = (size_t)HALF * K * 2;
    const size_t tstep = 2 * hstep;
    const unsigned ldsw = (unsigned)wid * 1024u;
    const int aoff = lds_byte(wr * 64 + fr, fq * 8), boff = lds_byte(wc * 32 + fr, fq * 8);
#define PG8_SA(b, h) (((b) * 2 + (h)) * HTB)
#define PG8_SB(b, h) ((4 + (b) * 2 + (h)) * HTB)
#define PG8_STAGE(bufoff, gbase, voff) do { _Pragma("unroll") for (int _i = 0; _i < 2; ++_i) \
        __builtin_amdgcn_global_load_lds((const unsigned*)((const char*)(gbase) + (voff)[_i]), (PG8_LAS unsigned*)(lds + (bufoff) + ldsw + _i * 8192), 16, 0, 0); } while (0)
#define PG8_LDA(dst, b, h) do { _Pragma("unroll") for (int m = 0; m < 4; ++m) _Pragma("unroll") for (int k = 0; k < 2; ++k) dst[m][k] = *(const PG8_LAS bf16x8*)(lds + PG8_SA(b, h) + aoff + m * 2048 + k * 1024); } while (0)
#define PG8_LDB(dst, b, h) do { _Pragma("unroll") for (int n = 0; n < 2; ++n) _Pragma("unroll") for (int k = 0; k < 2; ++k) dst[n][k] = *(const PG8_LAS bf16x8*)(lds + PG8_SB(b, h) + boff + n * 2048 + k * 1024); } while (0)
#define PG8_MMA(ai, bj, At, Bt) do { __builtin_amdgcn_s_setprio(1); _Pragma("unroll") for (int m = 0; m < 4; ++m) _Pragma("unroll") for (int n = 0; n < 2; ++n) _Pragma("unroll") for (int k = 0; k < 2; ++k) \
        acc[ai][bj][m][n] = __builtin_amdgcn_mfma_f32_16x16x32_bf16(Bt[n][k], At[m][k], acc[ai][bj][m][n], 0, 0, 0); __builtin_amdgcn_s_setprio(0); } while (0)
#define PG8_WAIT_V(n) asm volatile("s_waitcnt vmcnt(" #n ")" ::: "memory")
#define PG8_WAIT_L(n) asm volatile("s_waitcnt lgkmcnt(" #n ")" ::: "memory")
#define PG8_BAR __builtin_amdgcn_s_barrier()
#define PG8_SCHED __builtin_amdgcn_sched_barrier(0)
    Unit cur, nxt; int ui = 0;
    if (!S.next(0, cur)) return;
    f32x4 acc[2][2][4][2];
#pragma unroll
    for (int a = 0; a < 2; ++a)
#pragma unroll
        for (int b = 0; b < 2; ++b)
#pragma unroll
            for (int m = 0; m < 4; ++m)
#pragma unroll
                for (int n = 0; n < 2; ++n) acc[a][b][m][n] = (f32x4){0.f, 0.f, 0.f, 0.f};
    bf16x8 At[4][2], B0[2][2], B1[2][2];
    const char* cA = (const char*)g.A + (size_t)cur.pm * tstep; const char* cB = (const char*)g.Bt + (size_t)cur.pn * tstep;
    S.a_ready(cur);
    if constexpr (SP2) {
        PG8_STAGE(PG8_SB(0, 0), cB, voffB); PG8_STAGE(PG8_SB(0, 1), cB + hstep, voffB); PG8_STAGE(PG8_SA(0, 0), cA, voffA); PG8_STAGE(PG8_SA(0, 1), cA + hstep, voffA);
        if (wr == 1) PG8_BAR;
        PG8_WAIT_V(2); PG8_BAR;
        PG8_STAGE(PG8_SB(1, 0), cB + kstep, voffB); PG8_STAGE(PG8_SA(1, 0), cA + kstep, voffA); PG8_STAGE(PG8_SB(1, 1), cB + hstep + kstep, voffB);
        PG8_WAIT_V(6); PG8_BAR;
    } else {
        PG8_STAGE(PG8_SB(0, 0), cB, voffB); PG8_STAGE(PG8_SA(0, 0), cA, voffA); PG8_STAGE(PG8_SB(0, 1), cB + hstep, voffB); PG8_STAGE(PG8_SA(0, 1), cA + hstep, voffA);
        if (wr == 1) PG8_BAR;
        PG8_WAIT_V(4); PG8_BAR;
        PG8_STAGE(PG8_SB(1, 0), cB + kstep, voffB); PG8_STAGE(PG8_SA(1, 0), cA + kstep, voffA); PG8_STAGE(PG8_SB(1, 1), cB + hstep + kstep, voffB);
        PG8_WAIT_V(6); PG8_BAR;
    }
    for (;;) {
        const bool has_next = S.next(ui + 1, nxt);
        const char* nA = has_next ? (const char*)g.A + (size_t)nxt.pm * tstep : cA; const char* nB = has_next ? (const char*)g.Bt + (size_t)nxt.pn * tstep : cB;
        for (int t = 0; t < nt; t += 2) {
            const bool last = (t == nt - 2);
            const char* a1 = cA + (size_t)(t + 1) * kstep;
            const char* a2 = last ? nA : cA + (size_t)(t + 2) * kstep; const char* b2 = last ? nB : cB + (size_t)(t + 2) * kstep;
            const char* a3 = a2 + kstep; const char* b3 = b2 + kstep;
            if (last && has_next) S.a_ready(nxt);
            if constexpr (SP2) {
            PG8_LDB(B0, 0, 0); PG8_LDB(B1, 0, 1); PG8_SCHED; PG8_LDA(At, 0, 0); PG8_STAGE(PG8_SA(1, 1), a1 + hstep, voffA);
            PG8_WAIT_V(8); PG8_WAIT_L(0); PG8_BAR; PG8_MMA(0, 0, At, B0); PG8_MMA(0, 1, At, B1); PG8_BAR; PG8_SCHED;
            PG8_LDA(At, 0, 1); PG8_STAGE(PG8_SB(0, 0), b2, voffB); PG8_STAGE(PG8_SB(0, 1), b2 + hstep, voffB); PG8_STAGE(PG8_SA(0, 0), a2, voffA);
            PG8_WAIT_V(8); PG8_WAIT_L(0); PG8_BAR; PG8_MMA(1, 0, At, B0); PG8_MMA(1, 1, At, B1); PG8_BAR; PG8_SCHED;
            PG8_LDB(B0, 1, 0); PG8_LDB(B1, 1, 1); PG8_SCHED; PG8_LDA(At, 1, 0); PG8_STAGE(PG8_SA(0, 1), a2 + hstep, voffA);
            PG8_WAIT_V(8); PG8_WAIT_L(0); PG8_BAR; PG8_MMA(0, 0, At, B0); PG8_MMA(0, 1, At, B1); PG8_BAR; PG8_SCHED;
            PG8_LDA(At, 1, 1); PG8_STAGE(PG8_SB(1, 0), b3, voffB); PG8_STAGE(PG8_SB(1, 1), b3 + hstep, voffB); PG8_STAGE(PG8_SA(1, 0), a3, voffA);
            PG8_WAIT_V(8); PG8_WAIT_L(0); PG8_BAR; PG8_MMA(1, 0, At, B0); PG8_MMA(1, 1, At, B1); PG8_BAR; PG8_SCHED;
            } else {
            PG8_LDB(B0, 0, 0); PG8_SCHED; PG8_LDA(At, 0, 0); PG8_STAGE(PG8_SA(1, 1), a1 + hstep, voffA);
            PG8_WAIT_L(8); PG8_BAR; PG8_WAIT_L(0); PG8_MMA(0, 0, At, B0); PG8_BAR; PG8_SCHED;
            PG8_LDB(B1, 0, 1); PG8_STAGE(PG8_SB(0, 0), b2, voffB);
            PG8_BAR; PG8_WAIT_L(0); PG8_MMA(0, 1, At, B1); PG8_BAR;
            PG8_LDA(At, 0, 1); PG8_STAGE(PG8_SA(0, 0), a2, voffA);
            PG8_BAR; PG8_WAIT_L(0); PG8_MMA(1, 0, At, B0); PG8_BAR; PG8_SCHED;
            PG8_STAGE(PG8_SB(0, 1), b2 + hstep, voffB);
            PG8_WAIT_V(6); PG8_BAR; PG8_MMA(1, 1, At, B1); PG8_BAR;
            PG8_LDB(B0, 1, 0); PG8_SCHED; PG8_LDA(At, 1, 0); PG8_STAGE(PG8_SA(0, 1), a2 + hstep, voffA);
            PG8_WAIT_L(8); PG8_BAR; PG8_WAIT_L(0); PG8_MMA(0, 0, At, B0); PG8_BAR; PG8_SCHED;
            PG8_LDB(B1, 1, 1); PG8_STAGE(PG8_SB(1, 0), b3, voffB);
            PG8_BAR; PG8_WAIT_L(0); PG8_MMA(0, 1, At, B1); PG8_BAR;
            PG8_LDA(At, 1, 1); PG8_STAGE(PG8_SA(1, 0), a3, voffA);
            PG8_BAR; PG8_WAIT_L(0); PG8_MMA(1, 0, At, B0); PG8_BAR; PG8_SCHED;
            PG8_STAGE(PG8_SB(1, 1), b3 + hstep, voffB);
            PG8_WAIT_V(6); PG8_BAR; PG8_MMA(1, 1, At, B1); PG8_BAR;
            }
        }
        if constexpr (ALIGN_EPI) { if (wr == 0) PG8_BAR; }
        if constexpr (!Epi::AFTER_DRAIN) { E(acc, cur, wr, wc, fr, fq); S.done(cur); }
        if (!has_next) break;
#pragma unroll
        for (int a = 0; a < 2; ++a)
#pragma unroll
            for (int b = 0; b < 2; ++b)
#pragma unroll
                for (int m = 0; m < 4; ++m)
#pragma unroll
                    for (int n = 0; n < 2; ++n) acc[a][b][m][n] = (f32x4){0.f, 0.f, 0.f, 0.f};
        cur = nxt; cA = nA; cB = nB; ++ui;
        if constexpr (ALIGN_EPI) { if (wr == 1) PG8_BAR; }
    }
    PG8_WAIT_V(0);
    if constexpr (!ALIGN_EPI) { if (wr == 0) PG8_BAR; }
    PG8_BAR;
    if constexpr (Epi::AFTER_DRAIN) { E.fused(acc, cur, wr, wc, fr, fq, lds, wid, lane); S.done(cur); }
#undef PG8_SA
#undef PG8_SB
#undef PG8_STAGE
#undef PG8_LDA
#undef PG8_LDB
#undef PG8_MMA
#undef PG8_WAIT_V
#undef PG8_WAIT_L
#undef PG8_BAR
#undef PG8_SCHED
}
}
#ifndef PG8_SP2
#define PG8_SP2 true
#endif
#ifndef PG8_ALIGN
#define PG8_ALIGN true
#endif
constexpr int NWAVES = 8;
constexpr int D = 1024, NB = 8, SEQ = 2048, DECB = 128, DECT = 4, NMETA = 16;
constexpr int PW = 512, NH = 4, HD = 128, FF = 4096, INC = 2568, NIN = 2560;
constexpr int R_PROMPT = NB * SEQ;
constexpr int R_SAMPLE = DECB * DECT;
constexpr int R_MAIN = R_PROMPT + R_SAMPLE;
constexpr int R_META0 = R_MAIN;
constexpr int R_IN = R_MAIN + NMETA;
constexpr int M_IN = 17152;
constexpr int LP = SEQ + NMETA;
constexpr float EPS = 1e-6f;
constexpr size_t MiB = 1u << 20;
constexpr size_t WS_CTL = 0, CTL_ZERO_BYTES = 1 * MiB;
constexpr int CW_BAR = 4096;
constexpr size_t WS_WIN = 1 * MiB, WS_WOUT = 6 * MiB, WS_WUP = 8 * MiB, WS_WDN = 16 * MiB;
constexpr size_t WS_G = 24 * MiB;
constexpr size_t WS_XN = 25 * MiB;
constexpr size_t WS_P = 59 * MiB;
constexpr size_t P_STRIDE = (size_t)M_IN * 512;
constexpr size_t WS_MIX = 143 * MiB;
constexpr size_t WS_CST = 176 * MiB;
constexpr size_t WS_NST = 208 * MiB;
constexpr size_t WS_SCB = 208 * MiB + 512 * 1024;
constexpr size_t WS_SCM = WS_SCB + 288 * 1024;
constexpr size_t WS_M0 = WS_SCM + 288 * 1024;
constexpr size_t WS_WSA = WS_M0 + 8 * 1024;
constexpr size_t WS_DEC = WS_WSA + 288 * 1024;
constexpr size_t WS_WORAW = WS_DEC + 8 * 1024;
constexpr size_t WS_H = 59 * MiB;
constexpr size_t WS_SLAB = 212 * MiB;
constexpr size_t WS_END = 220 * MiB;
static_assert(WS_P + 5 * P_STRIDE * 2 <= WS_MIX && WS_MIX + (size_t)R_MAIN * 1024 * 2 <= WS_CST && WS_WORAW + 1024 * 512 * 2 <= WS_END && WS_H + (size_t)R_MAIN * FF * 2 <= WS_END, "d_ws map");
constexpr size_t O_Y = 0, O_POOLP = 17301504, O_CP = 17362944, O_NP = 17887232, O_MP = 17891328, O_POOLS = 17891360, O_CS = 18874400, O_NS = 27263008, O_MS = 27328544, O_END = 27329056;
constexpr int RING_BYTES = 131072, LDS_BYTES = 147456, MISC_OFF = RING_BYTES + 320;

#define GAS __attribute__((address_space(1)))
#define LAS __attribute__((address_space(3)))
typedef unsigned short bf16;
typedef unsigned v4u __attribute__((ext_vector_type(4)));
typedef unsigned v2u __attribute__((ext_vector_type(2)));
typedef float f32x4 __attribute__((ext_vector_type(4)));
typedef float f32x2 __attribute__((ext_vector_type(2)));
#define LDS_WAIT() asm volatile("s_waitcnt lgkmcnt(0)" ::: "memory")
#define VM_WAIT() asm volatile("s_waitcnt vmcnt(0)" ::: "memory")
__device__ __forceinline__ unsigned f2bf(float f) { unsigned u = __builtin_bit_cast(unsigned, f); return (u + 0x7fffu + ((u >> 16) & 1u)) >> 16; }
__device__ __forceinline__ unsigned pk2(float lo, float hi) { return f2bf(lo) | (f2bf(hi) << 16); }
__device__ __forceinline__ float bf2f(unsigned short b) { return __builtin_bit_cast(float, (unsigned)b << 16); }
__device__ __forceinline__ float bflo(unsigned w) { return __builtin_bit_cast(float, w << 16); }
__device__ __forceinline__ float bfhi(unsigned w) { return __builtin_bit_cast(float, w & 0xffff0000u); }
__device__ __forceinline__ float wave_sum(float v) {
#pragma unroll
    for (int o = 1; o < 64; o <<= 1) v += __shfl_xor(v, o);
    return v;
}
__device__ __forceinline__ float sigmoidf_(float x) { return 1.f / (1.f + __expf(-x)); }
__device__ __forceinline__ float logsigmoidf_(float x) { return fminf(x, 0.f) - log1pf(expf(-fabsf(x))); }

#define XB_TMO      128
#define XB_XCNT(j)  (256  + 64 * (j))
#define XB_XSUB(j)  (1280 + 64 * (j))
#define XB_XGEN(j)  (2304 + 64 * (j))
#define XB_TOP      3328
#define XB_TOPGEN   3392
#define XCD_BAR_WORDS 3456
#define XB_SPIN_CAP (1u << 18)

__device__ __forceinline__ unsigned xb_ld(unsigned* p)              { return __hip_atomic_load(p, __ATOMIC_RELAXED, __HIP_MEMORY_SCOPE_AGENT); }
__device__ __forceinline__ unsigned xb_add(unsigned* p, unsigned v) { return __hip_atomic_fetch_add(p, v, __ATOMIC_RELAXED, __HIP_MEMORY_SCOPE_AGENT); }
__device__ __forceinline__ unsigned xb_xcc_id() { return (unsigned)__builtin_amdgcn_s_getreg((3 << 11) | 20) & 0xFu; }
#define XB_SPIN(cond, bar) do { unsigned _sp = 0; while (cond) { __builtin_amdgcn_s_sleep(1); \
    if ((++_sp & 255u) == 0u) { if (xb_ld(&(bar)[XB_TMO])) break; if (_sp > XB_SPIN_CAP) { atomicAdd(&(bar)[XB_TMO], 1u); break; } } } } while (0)

struct XcdBarrier {
    unsigned* bar; unsigned x;
    volatile LAS unsigned* st;
};

__device__ __forceinline__ XcdBarrier xcd_barrier_post(unsigned* bar, volatile LAS unsigned* st) {
    XcdBarrier b; b.bar = bar; b.x = xb_xcc_id(); b.st = st;
    if (threadIdx.x == 0) (void)xb_add(&bar[XB_XCNT(b.x)], 1u);
    return b;
}
__device__ __forceinline__ void xcd_barrier_complete(unsigned* bar, unsigned x, unsigned& nloc, unsigned& nx) {
    const unsigned G = gridDim.x * gridDim.y * gridDim.z;
    unsigned sum, cnt, mine, sp = 0u;
    for (;;) {
        sum = 0u; cnt = 0u; mine = 0u;
#pragma unroll
        for (unsigned j = 0; j < 16; ++j) { const unsigned c = xb_ld(&bar[XB_XCNT(j)]); sum += c; cnt += (c > 0u) ? 1u : 0u; mine = (j == x) ? c : mine; }
        if (sum == G) break;
        __builtin_amdgcn_s_sleep(1);
        if ((++sp & 255u) == 0u) { if (xb_ld(&bar[XB_TMO])) break; if (sp > XB_SPIN_CAP) { atomicAdd(&bar[XB_TMO], 1u); break; } }
    }
    nloc = mine > 0u ? mine : 1u; nx = cnt > 0u ? cnt : 1u;
}

__device__ __forceinline__ void xcd_barrier(const XcdBarrier& b) {
    asm volatile("s_waitcnt vmcnt(0)" ::: "memory");
    __syncthreads();
    if (threadIdx.x == 0) {
        unsigned* bar = b.bar;
        __builtin_amdgcn_s_waitcnt(0);
        unsigned nloc = b.st[0], nx = b.st[1];
        if (nloc == 0u) { xcd_barrier_complete(bar, b.x, nloc, nx); b.st[0] = nloc; b.st[1] = nx; }
        const unsigned old = xb_add(&bar[XB_XSUB(b.x)], 1u);
        const unsigned gen = old / nloc;
        if (old + 1u == (gen + 1u) * nloc) {
            __builtin_amdgcn_fence(__ATOMIC_RELEASE, "agent");
            asm volatile("s_waitcnt vmcnt(0)" ::: "memory");
            const unsigned og = xb_add(&bar[XB_TOP], 1u);
            const unsigned tg = og / nx;
            if (og + 1u == (tg + 1u) * nx) xb_add(&bar[XB_TOPGEN], 1u);
            else XB_SPIN(xb_ld(&bar[XB_TOPGEN]) == tg, bar);
            __builtin_amdgcn_fence(__ATOMIC_ACQUIRE, "agent");
            xb_add(&bar[XB_XGEN(b.x)], 1u);
            asm volatile("s_waitcnt vmcnt(0)" ::: "memory");
        } else {
            XB_SPIN(xb_ld(&bar[XB_XGEN(b.x)]) == gen, bar);
            __builtin_amdgcn_fence(__ATOMIC_ACQUIRE, "agent");
            asm volatile("s_waitcnt vmcnt(0)" ::: "memory");
        }
    }
    __syncthreads();
}

struct Frame {
    LAS unsigned char* lds;
    int tid, lane, wave, G, gw, NGW;
    const float *x_prompt, *x_sample, *state_pool, *state_C, *state_n, *state_m, *meta, *norm1, *w_in, *b_gate, *w_pool, *pool_scale, *head_gain, *w_out, *norm2, *w_up, *w_down, *norm_f;
    float* out;
    bf16 *Win_t, *Wout_t, *Wup_t, *Wdn_t, *XN, *P, *MIX, *H;
    float *Gt, *NST, *SCB, *SCM, *M0, *WS, *DEC, *SLAB;
    bf16 *CST, *WoRaw;
};

__device__ __forceinline__ void p0_transpose_item(const float* W, int ldw, int ncols, bf16* WT, int ldt, const float* rowscale, LAS float* scr, int item, int lane) {
    const int nblk = ncols / 32, kb = item / nblk, nb = item % nblk, k0 = 64 * kb, n0 = 32 * nb;
#pragma unroll 8
    for (int i = 0; i < 32; ++i) { const int kk = 2 * i + (lane >> 5); float w = W[(size_t)(k0 + kk) * ldw + n0 + (lane & 31)]; if (rowscale) w *= rowscale[k0 + kk]; scr[kk * 33 + (lane & 31)] = w; }
    LDS_WAIT(); asm volatile("" ::: "memory");
    const int c = lane & 7;
#pragma unroll
    for (int j = 0; j < 4; ++j) { const int n = (lane >> 3) + 8 * j; const LAS float* s = scr + (8 * c) * 33 + n;
        v4u o; o.x = pk2(s[0 * 33], s[1 * 33]); o.y = pk2(s[2 * 33], s[3 * 33]); o.z = pk2(s[4 * 33], s[5 * 33]); o.w = pk2(s[6 * 33], s[7 * 33]);
        *(GAS v4u*)(WT + (size_t)(n0 + n) * ldt + k0 + 8 * c) = o; }
    LDS_WAIT(); asm volatile("" ::: "memory");
}
__device__ __forceinline__ const float* in_row_ptr(const Frame& F, int r) {
    return r < R_PROMPT ? F.x_prompt + (size_t)r * D : (r < R_MAIN ? F.x_sample + (size_t)(r - R_PROMPT) * D : F.meta + (size_t)(r - R_META0) * D);
}
__device__ __forceinline__ void rms_row_to_bf16(const float* xrow, const float* g, bf16* orow, int lane, f32x4 (&xn)[4]) {
    const GAS f32x4* xr = (const GAS f32x4*)xrow + lane; const GAS f32x4* gr = (const GAS f32x4*)g + lane;
    float s = 0.f;
#pragma unroll
    for (int j = 0; j < 4; ++j) { xn[j] = xr[64 * j]; s += (xn[j].x * xn[j].x + xn[j].y * xn[j].y) + (xn[j].z * xn[j].z + xn[j].w * xn[j].w); }
    const float r = 1.f / sqrtf(wave_sum(s) * (1.f / D) + EPS);
    GAS v2u* o8 = (GAS v2u*)orow + lane;
#pragma unroll
    for (int j = 0; j < 4; ++j) { xn[j] = xn[j] * r * gr[64 * j]; v2u w; w.x = pk2(xn[j].x, xn[j].y); w.y = pk2(xn[j].z, xn[j].w); o8[64 * j] = w; }
}
__device__ __forceinline__ void p0_prologue(Frame& F) {
    LAS float* scr = (LAS float*)(F.lds + F.wave * 8448);
    LAS float* wgL = (LAS float*)(F.lds + 69632);
    for (int e = F.tid; e < 8 * D; e += NWAVES * 64) { const int g = e >> 10, k = e & 1023; wgL[e] = F.w_in[(size_t)k * INC + NIN + g]; }
    constexpr int I_IN = (D / 64) * (NIN / 32), I_OT = (PW / 64) * (D / 32), I_OB = I_OT, I_UP = (D / 64) * (FF / 32), I_DN = (FF / 64) * (D / 32);
    constexpr int NITEMS = I_IN + I_OT + I_OB + I_UP + I_DN;
    for (int it = F.gw; it < NITEMS; it += F.NGW) {
        int r = it;
        if (r < I_IN) { p0_transpose_item(F.w_in, INC, NIN, F.Win_t, D, nullptr, scr, r, F.lane); continue; } r -= I_IN;
        if (r < I_OT) { p0_transpose_item(F.w_out, D, D, F.WoRaw, PW, nullptr, scr, r, F.lane); continue; } r -= I_OT;
        if (r < I_OB) { p0_transpose_item(F.w_out + (size_t)PW * D, D, D, F.Wout_t + PW, D, F.head_gain, scr, r, F.lane); continue; } r -= I_OB;
        if (r < I_UP) { p0_transpose_item(F.w_up, FF, FF, F.Wup_t, D, nullptr, scr, r, F.lane); continue; } r -= I_UP;
        p0_transpose_item(F.w_down, D, D, F.Wdn_t, FF, nullptr, scr, r, F.lane);
    }
    __syncthreads();
    for (int m = F.gw; m < M_IN; m += F.NGW) {
        bf16* orow = F.XN + (size_t)m * D;
        if (m >= R_IN) { GAS v2u* o8 = (GAS v2u*)orow + F.lane; v2u z; z.x = 0u; z.y = 0u;
#pragma unroll
            for (int j = 0; j < 4; ++j) o8[64 * j] = z;
            if (F.lane < 8) F.Gt[(size_t)m * 8 + F.lane] = 0.f;
            continue; }
        f32x4 xn[4];
        rms_row_to_bf16(in_row_ptr(F, m), F.norm1, orow, F.lane, xn);
        float gs[8];
#pragma unroll
        for (int g = 0; g < 8; ++g) { float s = 0.f;
#pragma unroll
            for (int j = 0; j < 4; ++j) { const f32x4 w = *(const LAS f32x4*)(wgL + g * D + 4 * F.lane + 256 * j); s += (xn[j].x * w.x + xn[j].y * w.y) + (xn[j].z * w.z + xn[j].w * w.w); }
            gs[g] = wave_sum(s); }
        float val = gs[0];
#pragma unroll
        for (int g = 1; g < 8; ++g) val = (F.lane == g) ? gs[g] : val;
        if (F.lane < 8) { val += F.b_gate[F.lane]; F.Gt[(size_t)m * 8 + F.lane] = (F.lane < 4) ? val : logsigmoidf_(val); }
    }
}

typedef short bf16x8 __attribute__((ext_vector_type(8)));
typedef short s16x4 __attribute__((ext_vector_type(4)));
typedef float f32x16 __attribute__((ext_vector_type(16)));
#define MFMA32(a, b, c) __builtin_amdgcn_mfma_f32_32x32x16_bf16((a), (b), (c), 0, 0, 0)
__device__ __forceinline__ s16x4 vtr(const LAS unsigned char* p) { return __builtin_bit_cast(s16x4, __builtin_amdgcn_ds_read_tr16_b64_v4i16((LAS s16x4*)p)); }
__device__ __forceinline__ bf16x8 cat8(s16x4 lo, s16x4 hi) { return __builtin_shufflevector(lo, hi, 0, 1, 2, 3, 4, 5, 6, 7); }
__device__ __forceinline__ unsigned cvtpk(float lo, float hi) { typedef __bf16 bf16x2_t __attribute__((ext_vector_type(2))); f32x2 v = {lo, hi}; bf16x2_t b = __builtin_convertvector(v, bf16x2_t); return __builtin_bit_cast(unsigned, b); }
constexpr int IMG_STRIDE = 320;
constexpr int IMG_BYTES = 64 * IMG_STRIDE;
__device__ __forceinline__ int chunk_T(int c) { return c ? 64 : 16; }
__device__ __forceinline__ int chunk_p0(int c) { return c ? NMETA + (c - 1) * 64 : 0; }
__device__ __forceinline__ int chunk_row0(int b, int c) { return c ? b * SEQ + (c - 1) * 64 : R_META0; }

__device__ __forceinline__ void s_scan(Frame& F, int bh) {
    const int b = bh >> 2, h = bh & 3, tid = F.tid, lane = F.lane, wave = F.wave;
    LAS float* sb = (LAS float*)F.lds; LAS float* sg = sb + 2080; LAS float* sig = sg + 2080; LAS float* sB = sig + 2080; LAS float* sMl = sB + 40; LAS float* sm0 = sMl + 40;
    for (int c = wave; c < 33; c += NWAVES) {
        const int T = chunk_T(c), p0 = chunk_p0(c), row0 = chunk_row0(b, c);
        float lf = 0.f, ig = -INFINITY;
        if (lane < T) { lf = F.Gt[(size_t)(row0 + lane) * 8 + 4 + h]; ig = F.Gt[(size_t)(row0 + lane) * 8 + h]; }
        float bs = lf;
#pragma unroll
        for (int o = 1; o < 64; o <<= 1) { const float t = __shfl_up(bs, o); if (lane >= o) bs += t; }
        float g = ig - bs;
#pragma unroll
        for (int o = 1; o < 64; o <<= 1) { const float t = __shfl_up(g, o); if (lane >= o) g = fmaxf(g, t); }
        if (lane < T) { sb[p0 + lane] = bs; sg[p0 + lane] = g; sig[p0 + lane] = ig; }
        const float Bc = __shfl(bs, T - 1), gl = __shfl(g, T - 1);
        if (lane == 0) { sB[c] = Bc; sMl[c] = Bc + gl; }
    }
    __syncthreads();
    if (tid == 0) { float m = 0.f; sm0[0] = 0.f; for (int c = 0; c < 33; ++c) { m = fmaxf(m + sB[c], sMl[c]); sm0[c + 1] = m; } }
    __syncthreads();
    for (int p = tid; p < LP; p += NWAVES * 64) { const int c = p < NMETA ? 0 : ((p - NMETA) >> 6) + 1;
        F.SCB[(size_t)bh * LP + p] = sb[p]; F.SCM[(size_t)bh * LP + p] = sb[p] + fmaxf(sm0[c], sg[p]); F.WS[(size_t)bh * LP + p] = __expf(sB[c] - sb[p] + sig[p] - sm0[c + 1]); }
    if (tid < 34) F.M0[bh * 34 + tid] = sm0[tid];
    if (tid < 33) F.DEC[bh * 33 + tid] = __expf(sB[tid] + sm0[tid] - sm0[tid + 1]);
    __syncthreads();
}
constexpr int CK_STRIDE = 64, CV_STRIDE = 192, CK_BYTES = 64 * CK_STRIDE, CV_BYTES = 64 * CV_STRIDE, CBUF_BYTES = CK_BYTES + CV_BYTES;
__device__ __forceinline__ void s_chain(Frame& F, int unit) {
    const int bh = unit >> 3, ki = (unit >> 1) & 3, vh = unit & 1, b = bh >> 2, h = bh & 3, tid = F.tid, lane = F.lane, wave = F.wave;
    const bf16* Kp = F.P + 2 * P_STRIDE + h * HD + 32 * ki; const bf16* Vp = F.P + 3 * P_STRIDE + h * HD + 64 * vh;
    const float* WSp = F.WS + (size_t)bh * LP; const float* DECp = F.DEC + bh * 33;
    const int i16 = lane & 15, q4 = i16 >> 2, p4 = i16 & 3, blk = (lane >> 4) & 1, hh = lane >> 5, r32 = lane & 31;
    const bool cwave = wave < 2, nwave = (wave == 2) && (vh == 0);
    f32x16 acc;
#pragma unroll
    for (int i = 0; i < 16; ++i) acc[i] = 0.f;
    bf16x8 ones;
#pragma unroll
    for (int j = 0; j < 8; ++j) ones[j] = (r32 == 0) ? (short)0x3F80 : (short)0;
    const int vrow = tid >> 3, vcc = tid & 7, krow = (tid & 255) >> 2, kcc = tid & 3; const bool kthr = tid < 256;
    v4u vA, vB, kA, kB; float wA = 0.f, wB = 0.f;
    kA = (v4u){0u, 0u, 0u, 0u}; kB = kA;
#define C_LOAD(c_, vS, kS, wS) do { const int T_ = chunk_T(c_), row0_ = chunk_row0(b, c_), p0_ = chunk_p0(c_); vS = (v4u){0u, 0u, 0u, 0u}; \
        if (vrow < T_) vS = *(const v4u*)(Vp + (size_t)(row0_ + vrow) * 512 + vcc * 8); \
        if (kthr) { kS = (v4u){0u, 0u, 0u, 0u}; wS = 0.f; if (krow < T_) { kS = *(const v4u*)(Kp + (size_t)(row0_ + krow) * 512 + kcc * 8); wS = WSp[p0_ + krow]; } } } while (0)
#define C_WRITE(vS, kS, wS, d_) do { *(LAS v4u*)(F.lds + (d_) * CBUF_BYTES + CK_BYTES + vrow * CV_STRIDE + vcc * 16) = vS; \
        if (kthr) { v4u w = kS; w.x = cvtpk(bflo(w.x) * wS, bfhi(w.x) * wS); w.y = cvtpk(bflo(w.y) * wS, bfhi(w.y) * wS); w.z = cvtpk(bflo(w.z) * wS, bfhi(w.z) * wS); w.w = cvtpk(bflo(w.w) * wS, bfhi(w.w) * wS); \
            *(LAS v4u*)(F.lds + (d_) * CBUF_BYTES + krow * CK_STRIDE + kcc * 16) = w; } } while (0)
#define C_COMPUTE(c_) do { const int cc_ = (c_); if (cwave || nwave) { const float dec = DECp[cc_]; \
        if (cc_ >= 1) { if (cwave) { bf16* Cs = F.CST + ((size_t)(bh * 32 + (cc_ - 1)) * HD + 64 * vh + 32 * wave + r32) * HD + 32 * ki + 4 * hh; \
                _Pragma("unroll") for (int g = 0; g < 4; ++g) { v2u w0; w0.x = cvtpk(acc[4 * g], acc[4 * g + 1]); w0.y = cvtpk(acc[4 * g + 2], acc[4 * g + 3]); *(v2u*)(Cs + 8 * g) = w0; } } \
            else if (r32 == 0) { float* Ns = F.NST + (size_t)(bh * 32 + (cc_ - 1)) * HD + 32 * ki + 4 * hh; \
                _Pragma("unroll") for (int g = 0; g < 4; ++g) { f32x4 o; o.x = acc[4 * g]; o.y = acc[4 * g + 1]; o.z = acc[4 * g + 2]; o.w = acc[4 * g + 3]; *(f32x4*)(Ns + 8 * g) = o; } } } \
        const LAS unsigned char* kb = F.lds + (cc_ & 1) * CBUF_BYTES; const LAS unsigned char* vb = kb + CK_BYTES; \
        bf16x8 Af[4], Bf[4]; \
        _Pragma("unroll") for (int s = 0; s < 4; ++s) { const int rlo = 16 * s + 8 * hh + q4; \
            Af[s] = cat8(vtr(kb + rlo * CK_STRIDE + 2 * (16 * blk + 4 * p4)), vtr(kb + (rlo + 4) * CK_STRIDE + 2 * (16 * blk + 4 * p4))); \
            if (cwave) Bf[s] = cat8(vtr(vb + rlo * CV_STRIDE + 2 * (32 * wave + 16 * blk + 4 * p4)), vtr(vb + (rlo + 4) * CV_STRIDE + 2 * (32 * wave + 16 * blk + 4 * p4))); else Bf[s] = ones; } \
        _Pragma("unroll") for (int i = 0; i < 16; ++i) acc[i] *= dec; \
        _Pragma("unroll") for (int s = 0; s < 4; ++s) acc = MFMA32(Af[s], Bf[s], acc); } } while (0)
    C_LOAD(0, vA, kA, wA); C_WRITE(vA, kA, wA, 0); C_LOAD(1, vA, kA, wA);
    __syncthreads();
    for (int c = 0; c < 32; c += 2) {
        C_LOAD(c + 2, vB, kB, wB); C_COMPUTE(c); C_WRITE(vA, kA, wA, 1); __syncthreads();
        if (c + 3 < 33) C_LOAD(c + 3, vA, kA, wA);
        C_COMPUTE(c + 1); C_WRITE(vB, kB, wB, 0); __syncthreads();
    }
    C_COMPUTE(32);
#undef C_LOAD
#undef C_WRITE
#undef C_COMPUTE
    if (cwave) { float* Co = F.out + O_CP + (size_t)bh * HD * HD + 64 * vh + 32 * wave + r32;
#pragma unroll
        for (int i = 0; i < 16; ++i) Co[(size_t)(32 * ki + (i & 3) + 8 * (i >> 2) + 4 * hh) * HD] = acc[i]; }
    if (nwave && r32 == 0) {
#pragma unroll
        for (int i = 0; i < 16; ++i) F.out[O_NP + bh * HD + 32 * ki + (i & 3) + 8 * (i >> 2) + 4 * hh] = acc[i]; }
    if (unit == (bh << 3) && tid == 0) F.out[O_MP + bh] = F.M0[bh * 34 + 33];
    __syncthreads();
}

__device__ __forceinline__ void s_sample_pair(Frame& F, int pair) {
    const int lane = F.lane, wave = F.wave, w4 = wave & 3, task = 2 * pair + (wave >> 2);
    const int bs = task >> 2, h = task & 3, rowb = R_PROMPT + bs * DECT;
    LAS float* red = (LAS float*)F.lds + (wave >> 2) * (4 * 4 * HD);
    const float* Ci = F.state_C + (size_t)task * HD * HD; float* Co = F.out + O_CS + (size_t)task * HD * HD;
    f32x2 c2[32];
#pragma unroll
    for (int r = 0; r < 32; ++r) c2[r] = *(const f32x2*)(Ci + (size_t)(w4 * 32 + r) * HD + 2 * lane);
    float lf[4], ig[4], bt[4], mt[4];
    float q[4][2], k[4][2], vv[4][2], kw[4][2], n0[2];
    unsigned short qs_[4][2], ks_[4][2]; unsigned vw_[4];
#pragma unroll
    for (int t = 0; t < 4; ++t) {
        lf[t] = F.Gt[(size_t)(rowb + t) * 8 + 4 + h]; ig[t] = F.Gt[(size_t)(rowb + t) * 8 + h];
        const bf16* qr = F.P + 1 * P_STRIDE + (size_t)(rowb + t) * 512 + h * HD; const bf16* kr = F.P + 2 * P_STRIDE + (size_t)(rowb + t) * 512 + h * HD; const bf16* vr = F.P + 3 * P_STRIDE + (size_t)(rowb + t) * 512 + h * HD;
        qs_[t][0] = qr[lane]; qs_[t][1] = qr[lane + 64]; ks_[t][0] = kr[lane]; ks_[t][1] = kr[lane + 64]; vw_[t] = *(const unsigned*)(vr + 2 * lane);
    }
    const float m0 = F.state_m[task];
    n0[0] = F.state_n[task * HD + lane]; n0[1] = F.state_n[task * HD + lane + 64];
    const unsigned ow = *(const unsigned*)(F.P + 4 * P_STRIDE + (size_t)(rowb + w4) * 512 + h * HD + 2 * lane);
    { float mp = m0, ba = 0.f;
#pragma unroll
      for (int t = 0; t < 4; ++t) { ba += lf[t]; bt[t] = ba; mt[t] = fmaxf(lf[t] + mp, ig[t]); mp = mt[t]; } }
    const float ml = mt[3], dec = __expf(bt[3] + m0 - ml);
#pragma unroll
    for (int t = 0; t < 4; ++t) { q[t][0] = bf2f(qs_[t][0]); q[t][1] = bf2f(qs_[t][1]); k[t][0] = bf2f(ks_[t][0]); k[t][1] = bf2f(ks_[t][1]); vv[t][0] = bflo(vw_[t]); vv[t][1] = bfhi(vw_[t]);
        const float ws = __expf(bt[3] - bt[t] + ig[t] - ml); kw[t][0] = ws * k[t][0]; kw[t][1] = ws * k[t][1]; }
    float Pm[4][4], den[4], inter[4];
#pragma unroll
    for (int t = 0; t < 4; ++t) {
        inter[t] = __expf(bt[t] + m0 - mt[t]);
        float dsum = inter[t] * wave_sum(q[t][0] * n0[0] + q[t][1] * n0[1]);
#pragma unroll
        for (int s = 0; s < 4; ++s) { if (s <= t) { Pm[t][s] = wave_sum(q[t][0] * k[s][0] + q[t][1] * k[s][1]) * __expf(bt[t] - bt[s] + ig[s] - mt[t]); dsum += Pm[t][s]; } else Pm[t][s] = 0.f; }
        den[t] = fmaxf(fabsf(dsum), __expf(-mt[t]));
    }
    if (w4 == 0) { F.out[O_NS + task * HD + lane] = dec * n0[0] + (kw[0][0] + kw[1][0]) + (kw[2][0] + kw[3][0]); F.out[O_NS + task * HD + lane + 64] = dec * n0[1] + (kw[0][1] + kw[1][1]) + (kw[2][1] + kw[3][1]);
        if (lane == 0) F.out[O_MS + task] = ml; }
    float np[4][2];
#pragma unroll
    for (int t = 0; t < 4; ++t) { np[t][0] = 0.f; np[t][1] = 0.f; }
    LAS float* tab = (LAS float*)F.lds + 8192 + wave * 1024;
    { f32x4 x; x.x = q[0][0]; x.y = q[1][0]; x.z = q[2][0]; x.w = q[3][0]; *(LAS f32x4*)(tab + 8 * lane) = x; x.x = kw[0][0]; x.y = kw[1][0]; x.z = kw[2][0]; x.w = kw[3][0]; *(LAS f32x4*)(tab + 8 * lane + 4) = x;
      x.x = q[0][1]; x.y = q[1][1]; x.z = q[2][1]; x.w = q[3][1]; *(LAS f32x4*)(tab + 8 * (lane + 64)) = x; x.x = kw[0][1]; x.y = kw[1][1]; x.z = kw[2][1]; x.w = kw[3][1]; *(LAS f32x4*)(tab + 8 * (lane + 64) + 4) = x; }
    LDS_WAIT(); asm volatile("" ::: "memory");
#pragma unroll
    for (int r = 0; r < 32; ++r) {
        const f32x4 qs = *(const LAS f32x4*)(tab + 8 * (w4 * 32 + r)), ks = *(const LAS f32x4*)(tab + 8 * (w4 * 32 + r) + 4);
        float o0 = dec * c2[r].x, o1 = dec * c2[r].y;
#pragma unroll
        for (int t = 0; t < 4; ++t) { o0 += ks[t] * vv[t][0]; o1 += ks[t] * vv[t][1]; np[t][0] += qs[t] * c2[r].x; np[t][1] += qs[t] * c2[r].y; }
        f32x2 o; o.x = o0; o.y = o1; *(f32x2*)(Co + (size_t)(w4 * 32 + r) * HD + 2 * lane) = o;
    }
#pragma unroll
    for (int t = 0; t < 4; ++t) { f32x2 o; o.x = np[t][0]; o.y = np[t][1]; *(LAS f32x2*)(red + (w4 * 4 + t) * HD + 2 * lane) = o; }
    __syncthreads();
#pragma unroll
    for (int t = 0; t < 4; ++t) if (w4 == t) {
        float a0 = 0.f, a1 = 0.f;
#pragma unroll
        for (int w = 0; w < 4; ++w) { const f32x2 x = *(const LAS f32x2*)(red + (w * 4 + t) * HD + 2 * lane); a0 += x.x; a1 += x.y; }
        a0 *= inter[t]; a1 *= inter[t];
#pragma unroll
        for (int s = 0; s < 4; ++s) if (s <= t) { a0 += Pm[t][s] * vv[s][0]; a1 += Pm[t][s] * vv[s][1]; }
        const float h0 = a0 / den[t], h1 = a1 / den[t];
        const float rn = 1.f / sqrtf(wave_sum(h0 * h0 + h1 * h1) * (1.f / HD) + EPS);
        *(unsigned*)(F.MIX + (size_t)(rowb + t) * D + PW + h * HD + 2 * lane) = pk2(h0 * rn * sigmoidf_(bflo(ow)), h1 * rn * sigmoidf_(bfhi(ow)));
    }
    __syncthreads();
}
__device__ __forceinline__ void p2_state(Frame& F) {
    for (int u = (int)blockIdx.x; u < NB * NH * 8; u += F.G) s_chain(F, u);
    for (int pair = (int)blockIdx.x; pair < DECB * NH / 2; pair += F.G) s_sample_pair(F, pair);
}

#define SCHED_FENCE() __builtin_amdgcn_sched_barrier(0)
__device__ __forceinline__ void mlstm_out_unit(Frame& F, int u) {
    const int lane = F.lane, wave = F.wave, tid = F.tid;
    const int i16 = lane & 15, q4 = i16 >> 2, p4 = i16 & 3, blk = (lane >> 4) & 1, hh = lane >> 5, r32 = lane & 31;
    const int b = u >> 5, c = (u & 31) + 1, row0 = b * SEQ + (c - 1) * 64, p0 = NMETA + (c - 1) * 64;
    LAS float* sa = (LAS float*)(F.lds + 4 * IMG_BYTES);
    const int h = wave >> 1, th = wave & 1, bh = b * 4 + h;
    const int t = 32 * th + r32, row = row0 + t;
    v4u vw[8];
#pragma unroll
    for (int i = 0; i < 8; ++i) { const int id = tid + 512 * i, vr = id >> 6, cc = id & 63; vw[i] = *(const v4u*)(F.P + 3 * P_STRIDE + (size_t)(row0 + vr) * 512 + cc * 8); }
    float av = 0.f;
    if (tid < 256) { const int hd = tid >> 6, s = tid & 63; av = F.Gt[(size_t)(row0 + s) * 8 + hd] - F.SCB[(size_t)((b * 4 + hd)) * LP + p0 + s]; }
    const float bt = F.SCB[(size_t)bh * LP + p0 + t], mt = F.SCM[(size_t)bh * LP + p0 + t], m0c = F.M0[bh * 34 + c];
    bf16x8 qf[8];
#pragma unroll
    for (int s = 0; s < 8; ++s) qf[s] = *(const bf16x8*)(F.P + 1 * P_STRIDE + (size_t)row * 512 + h * HD + 16 * s + 8 * hh);
    f32x4 n0v[16];
    { const float* Ns = F.NST + (size_t)(bh * 32 + (c - 1)) * HD + 8 * hh;
#pragma unroll
      for (int s = 0; s < 8; ++s) { n0v[2 * s] = *(const f32x4*)(Ns + 16 * s); n0v[2 * s + 1] = *(const f32x4*)(Ns + 16 * s + 4); } }
    const bf16* Cs = F.CST + ((size_t)(bh * 32 + (c - 1)) * HD) * HD + (size_t)r32 * HD + 8 * hh;
    bf16x8 A0[8], A1[8];
#pragma unroll
    for (int s = 0; s < 8; ++s) A0[s] = *(const bf16x8*)(Cs + (size_t)(0 * 32) * HD + 16 * s);
    SCHED_FENCE();
#pragma unroll
    for (int i = 0; i < 8; ++i) { const int id = tid + 512 * i, vr = id >> 6, cc = id & 63; *(LAS v4u*)(F.lds + (cc >> 4) * IMG_BYTES + vr * IMG_STRIDE + (cc & 15) * 16) = vw[i]; }
    if (tid < 256) sa[tid] = av;
    SCHED_FENCE();
#pragma unroll
    for (int s = 0; s < 8; ++s) A1[s] = *(const bf16x8*)(Cs + (size_t)(1 * 32) * HD + 16 * s);
    __syncthreads();
    const float ct = bt - mt, inter = __expf(bt + m0c - mt), emt = __expf(-mt);
    float qn = 0.f;
#pragma unroll
    for (int s = 0; s < 8; ++s) { const f32x4 n0a = n0v[2 * s], n0b = n0v[2 * s + 1]; const v4u qw = __builtin_bit_cast(v4u, qf[s]);
        qn += (bflo(qw.x) * n0a.x + bfhi(qw.x) * n0a.y) + (bflo(qw.y) * n0a.z + bfhi(qw.y) * n0a.w) + (bflo(qw.z) * n0b.x + bfhi(qw.z) * n0b.y) + (bflo(qw.w) * n0b.z + bfhi(qw.w) * n0b.w); }
    qn += __shfl_xor(qn, 32);
    SCHED_FENCE();
    f32x16 OT[4];
#pragma unroll
    for (int vt = 0; vt < 4; ++vt)
#pragma unroll
        for (int i = 0; i < 16; ++i) OT[vt][i] = 0.f;
#pragma unroll
    for (int s = 0; s < 8; ++s) OT[0] = MFMA32(A0[s], qf[s], OT[0]);
    SCHED_FENCE();
#pragma unroll
    for (int s = 0; s < 8; ++s) A0[s] = *(const bf16x8*)(Cs + (size_t)(2 * 32) * HD + 16 * s);
    SCHED_FENCE();
#pragma unroll
    for (int s = 0; s < 8; ++s) OT[1] = MFMA32(A1[s], qf[s], OT[1]);
    SCHED_FENCE();
#pragma unroll
    for (int s = 0; s < 8; ++s) A1[s] = *(const bf16x8*)(Cs + (size_t)(3 * 32) * HD + 16 * s);
    SCHED_FENCE();
#pragma unroll
    for (int s = 0; s < 8; ++s) OT[2] = MFMA32(A0[s], qf[s], OT[2]);
    SCHED_FENCE();
    const bf16* Kr = F.P + 2 * P_STRIDE + (size_t)(row0 + r32) * 512 + h * HD + 8 * hh;
#pragma unroll
    for (int s = 0; s < 8; ++s) A0[s] = *(const bf16x8*)(Kr + 16 * s);
    SCHED_FENCE();
#pragma unroll
    for (int s = 0; s < 8; ++s) OT[3] = MFMA32(A1[s], qf[s], OT[3]);
    SCHED_FENCE();
    if (th) {
#pragma unroll
        for (int s = 0; s < 8; ++s) A1[s] = *(const bf16x8*)(Kr + (size_t)32 * 512 + 16 * s);
    }
    SCHED_FENCE();
#pragma unroll
    for (int vt = 0; vt < 4; ++vt)
#pragma unroll
        for (int i = 0; i < 16; ++i) OT[vt][i] *= inter;
    float csum = 0.f;
    const LAS unsigned char* vimg = F.lds + h * IMG_BYTES;
#pragma unroll
    for (int stile = 0; stile < 2; ++stile) if (stile <= th) {
        f32x16 ST;
#pragma unroll
        for (int i = 0; i < 16; ++i) ST[i] = 0.f;
        if (stile == 0) {
#pragma unroll
            for (int s = 0; s < 8; ++s) ST = MFMA32(A0[s], qf[s], ST);
        } else {
#pragma unroll
            for (int s = 0; s < 8; ++s) ST = MFMA32(A1[s], qf[s], ST);
        }
        const float pen = (stile == th) ? 1e30f : 0.f, tl = (float)(r32 - 4 * hh);
#pragma unroll
        for (int g = 0; g < 4; ++g) { const f32x4 as4 = *(const LAS f32x4*)(sa + h * 64 + 32 * stile + 8 * g + 4 * hh);
#pragma unroll
            for (int e = 0; e < 4; ++e) { const float dv = __expf(fminf(tl - (float)(8 * g + e), 0.f) * pen + (ct + as4[e])); const float pv = ST[4 * g + e] * dv; ST[4 * g + e] = pv; csum += pv; } }
#pragma unroll
        for (int ks = 0; ks < 2; ++ks) {
            v4u pw; pw.x = cvtpk(ST[8 * ks], ST[8 * ks + 1]); pw.y = cvtpk(ST[8 * ks + 2], ST[8 * ks + 3]); pw.z = cvtpk(ST[8 * ks + 4], ST[8 * ks + 5]); pw.w = cvtpk(ST[8 * ks + 6], ST[8 * ks + 7]);
            const bf16x8 Pf = __builtin_bit_cast(bf16x8, pw);
            const int rlo = 32 * stile + 16 * ks + 4 * hh + q4;
            bf16x8 Vf[4];
#pragma unroll
            for (int vt = 0; vt < 4; ++vt) Vf[vt] = cat8(vtr(vimg + rlo * IMG_STRIDE + 2 * (32 * vt + 16 * blk + 4 * p4)), vtr(vimg + (rlo + 8) * IMG_STRIDE + 2 * (32 * vt + 16 * blk + 4 * p4)));
#pragma unroll
            for (int vt = 0; vt < 4; ++vt) OT[vt] = MFMA32(Vf[vt], Pf, OT[vt]);
        }
    }
    v2u ow[16];
#pragma unroll
    for (int vt = 0; vt < 4; ++vt)
#pragma unroll
        for (int g = 0; g < 4; ++g) ow[4 * vt + g] = *(const v2u*)(F.P + 4 * P_STRIDE + (size_t)row * 512 + h * HD + 32 * vt + 8 * g + 4 * hh);
    SCHED_FENCE();
    csum += __shfl_xor(csum, 32);
    const float den = fmaxf(fabsf(inter * qn + csum), emt), rden = 1.f / den;
    float ss = 0.f;
#pragma unroll
    for (int vt = 0; vt < 4; ++vt)
#pragma unroll
        for (int i = 0; i < 16; ++i) { OT[vt][i] *= rden; ss += OT[vt][i] * OT[vt][i]; }
    ss += __shfl_xor(ss, 32);
    const float rn = 1.f / sqrtf(ss * (1.f / HD) + EPS);
#pragma unroll
    for (int vt = 0; vt < 4; ++vt)
#pragma unroll
        for (int g = 0; g < 4; ++g) { const int v0 = 32 * vt + 8 * g + 4 * hh; const v2u o2 = ow[4 * vt + g];
            v2u w; w.x = cvtpk(OT[vt][4 * g] * rn * sigmoidf_(bflo(o2.x)), OT[vt][4 * g + 1] * rn * sigmoidf_(bfhi(o2.x)));
            w.y = cvtpk(OT[vt][4 * g + 2] * rn * sigmoidf_(bflo(o2.y)), OT[vt][4 * g + 3] * rn * sigmoidf_(bfhi(o2.y)));
            *(v2u*)(F.MIX + (size_t)row * D + PW + h * HD + v0) = w; }
    __syncthreads();
}

template <int NT> __device__ __forceinline__ void pool_tokens(const v4u (&rw)[15 + NT], int g, bf16* dst  ) {
    const float invw = g == 0 ? 0.5f : g == 1 ? 0.25f : g == 2 ? 0.125f : 0.0625f, m4 = g >= 1 ? 1.f : 0.f, m8 = g >= 2 ? 1.f : 0.f, m16 = g >= 3 ? 1.f : 0.f;
    unsigned ow[NT][4];
#pragma unroll
    for (int k = 0; k < 4; ++k) {
        float lo[15 + NT], hi[15 + NT];
#pragma unroll
        for (int i = 0; i < 15 + NT; ++i) { const unsigned w = rw[i][k]; lo[i] = bflo(w); hi[i] = bfhi(w); }
#pragma unroll
        for (int t = 0; t < NT; ++t) { const int i = 15 + t;
            const float a2 = lo[i] + lo[i - 1], a4 = lo[i - 2] + lo[i - 3], a8 = (lo[i - 4] + lo[i - 5]) + (lo[i - 6] + lo[i - 7]);
            const float a16 = ((lo[i - 8] + lo[i - 9]) + (lo[i - 10] + lo[i - 11])) + ((lo[i - 12] + lo[i - 13]) + (lo[i - 14] + lo[i - 15]));
            const float b2 = hi[i] + hi[i - 1], b4 = hi[i - 2] + hi[i - 3], b8 = (hi[i - 4] + hi[i - 5]) + (hi[i - 6] + hi[i - 7]);
            const float b16 = ((hi[i - 8] + hi[i - 9]) + (hi[i - 10] + hi[i - 11])) + ((hi[i - 12] + hi[i - 13]) + (hi[i - 14] + hi[i - 15]));
            const float pa = (a2 + m4 * a4 + m8 * a8 + m16 * a16) * invw - lo[i];
            const float pb = (b2 + m4 * b4 + m8 * b8 + m16 * b16) * invw - hi[i];
            ow[t][k] = cvtpk(pa, pb); }
    }
#pragma unroll
    for (int t = 0; t < NT; ++t) { v4u w; w.x = ow[t][0]; w.y = ow[t][1]; w.z = ow[t][2]; w.w = ow[t][3]; *(v4u*)(dst + (size_t)t * D) = w; }
}
__device__ __forceinline__ void pool_unit(Frame& F, int u) {
    const int lane = F.lane, wave = F.wave;
    const bf16* U = F.P;
    const int g_l = lane >> 4;
    if (u < NB * 32) {
        const int b = u >> 5, tr0 = (u & 31) * 64;
        v4u rw[23];
#pragma unroll
        for (int i = 0; i < 23; ++i) { const int tr = tr0 + 8 * wave - 15 + i; const int r = tr >= 0 ? b * SEQ + tr : R_META0 + NMETA + tr; rw[i] = *(const v4u*)(U + (size_t)r * 512 + 8 * lane); }
        pool_tokens<8>(rw, g_l, F.MIX + (size_t)(b * SEQ + tr0 + 8 * wave) * D + 8 * lane);
    } else {
        const int su = u - NB * 32;
#pragma unroll
        for (int sq = 0; sq < 2; ++sq) { const int seq = su * 16 + 2 * wave + sq;
            v4u rw[19];
#pragma unroll
            for (int i = 0; i < 15; ++i) { const float* cr = F.state_pool + ((size_t)seq * 15 + i) * 512 + 8 * lane; const f32x4 x0 = *(const f32x4*)cr, x1 = *(const f32x4*)(cr + 4);
                rw[i].x = cvtpk(x0.x, x0.y); rw[i].y = cvtpk(x0.z, x0.w); rw[i].z = cvtpk(x1.x, x1.y); rw[i].w = cvtpk(x1.z, x1.w); }
#pragma unroll
            for (int i = 0; i < 4; ++i) rw[15 + i] = *(const v4u*)(U + (size_t)(R_PROMPT + seq * DECT + i) * 512 + 8 * lane);
            pool_tokens<4>(rw, g_l, F.MIX + (size_t)(R_PROMPT + seq * DECT) * D + 8 * lane); }
    }
}
__device__ __forceinline__ void p3_out(Frame& F) {
    for (int u = (int)blockIdx.x; u < NB * 32; u += F.G) mlstm_out_unit(F, u);
    for (int u = (int)blockIdx.x; u < NB * 32 + R_SAMPLE / 64; u += F.G) pool_unit(F, u);
}

__device__ __forceinline__ void fold_pool_tile(Frame& F, int id) {
    const int g = id >> 7, n0 = 32 * ((id >> 2) & 31), c0 = 32 * (id & 3), lane = F.lane, r32 = lane & 31, hh = lane >> 5;
    f32x16 acc;
#pragma unroll
    for (int i = 0; i < 16; ++i) acc[i] = 0.f;
    bf16x8 A[8]; f32x4 wa[8], wb[8], sa_[8], sb_[8];
#pragma unroll
    for (int s = 0; s < 8; ++s) { A[s] = *(const bf16x8*)(F.WoRaw + (size_t)(n0 + r32) * PW + g * 128 + 16 * s + 8 * hh);
        const float* wp = F.w_pool + (size_t)g * 16384 + (size_t)(c0 + r32) * 128 + 16 * s + 8 * hh; const float* sc = F.pool_scale + g * 128 + 16 * s + 8 * hh;
        wa[s] = *(const f32x4*)wp; wb[s] = *(const f32x4*)(wp + 4); sa_[s] = *(const f32x4*)sc; sb_[s] = *(const f32x4*)(sc + 4); }
#pragma unroll
    for (int s = 0; s < 8; ++s) { const f32x4 x = wa[s] * sa_[s], y = wb[s] * sb_[s]; v4u w; w.x = cvtpk(x.x, x.y); w.y = cvtpk(x.z, x.w); w.z = cvtpk(y.x, y.y); w.w = cvtpk(y.z, y.w);
        acc = MFMA32(A[s], __builtin_bit_cast(bf16x8, w), acc); }
#pragma unroll
    for (int i = 0; i < 16; ++i) { const int n = n0 + (i & 3) + 8 * (i >> 2) + 4 * hh; F.Wout_t[(size_t)n * D + g * 128 + c0 + r32] = (bf16)f2bf(acc[i]); }
}

__device__ __forceinline__ void p3_poolstate(Frame& F) {
    const int gt = blockIdx.x * (NWAVES * 64) + F.tid, ngt = F.G * NWAVES * 64;
    for (int e = gt; e < NB * 15 * 512; e += ngt) { const int c = e & 511, i = (e >> 9) % 15, b = e / (15 * 512); F.out[O_POOLP + e] = bf2f(F.P[(size_t)(b * SEQ + SEQ - 15 + i) * 512 + c]); }
    for (int e = gt; e < DECB * 15 * 512; e += ngt) { const int c = e & 511, i = (e >> 9) % 15, b = e / (15 * 512);
        F.out[O_POOLS + e] = (i < 11) ? F.state_pool[((size_t)b * 15 + i + 4) * 512 + c] : bf2f(F.P[(size_t)(R_PROMPT + b * DECT + (i - 11)) * 512 + c]); }
}

template <int EPI> __device__ __forceinline__ void small_gemm_tile(Frame& F, const bf16* A, int lda, const bf16* Wt, int ldw, int k0, int nk, int m0, int n0, const float* res, void* outp, int ldo) {
    const int tid = F.tid, lane = F.lane, wave = F.wave, wm = wave >> 2, wn = wave & 3, r32 = lane & 31, hh = lane >> 5;
    constexpr int BUF = 24576, AOFF = 0, WOFF = 8192;
    const int arow = tid >> 3, ach = tid & 7;
    const bf16* ag = A + (size_t)(m0 + arow) * lda + k0 + ach * 8; const bf16* wg0 = Wt + (size_t)(n0 + arow) * ldw + k0 + ach * 8; const bf16* wg1 = wg0 + (size_t)64 * ldw;
    const int sw = (ach ^ (arow & 7)) * 16;
    v4u ra[4], rw0[4], rw1[4];
    f32x16 acc;
#pragma unroll
    for (int i = 0; i < 16; ++i) acc[i] = 0.f;
#define SG_LOAD(j, kt_) do { ra[j] = *(const v4u*)(ag + (kt_) * 64); rw0[j] = *(const v4u*)(wg0 + (kt_) * 64); rw1[j] = *(const v4u*)(wg1 + (kt_) * 64); } while (0)
#define SG_WRITE(j, d_) do { LAS unsigned char* nb = F.lds + (d_) * BUF; *(LAS v4u*)(nb + AOFF + arow * 128 + sw) = ra[j]; *(LAS v4u*)(nb + WOFF + arow * 128 + sw) = rw0[j]; *(LAS v4u*)(nb + WOFF + (arow + 64) * 128 + sw) = rw1[j]; } while (0)
#define SG_STEP(j) do { const int kt_ = kt + (j); const LAS unsigned char* buf = F.lds + ((j) & 1) * BUF; \
        bf16x8 wf[4], xf[4]; \
        _Pragma("unroll") for (int s = 0; s < 4; ++s) { wf[s] = *(const LAS bf16x8*)(buf + WOFF + wrow * 128 + (((2 * s + hh) ^ (wrow & 7)) * 16)); xf[s] = *(const LAS bf16x8*)(buf + AOFF + xrow * 128 + (((2 * s + hh) ^ (xrow & 7)) * 16)); } \
        if (kt_ + 4 < nk) SG_LOAD(j, kt_ + 4); \
        _Pragma("unroll") for (int s = 0; s < 4; ++s) acc = MFMA32(wf[s], xf[s], acc); \
        if (kt_ + 1 < nk) SG_WRITE(((j) + 1) & 3, ((j) + 1) & 1); \
        __syncthreads(); } while (0)
    const int wrow = 32 * wn + r32, xrow = 32 * wm + r32;
    SG_LOAD(0, 0); SG_LOAD(1, 1); SG_LOAD(2, 2); SG_LOAD(3, 3);
    SG_WRITE(0, 0);
    __syncthreads();
    for (int kt = 0; kt < nk; kt += 4) { SG_STEP(0); SG_STEP(1); SG_STEP(2); SG_STEP(3); }
#undef SG_LOAD
#undef SG_WRITE
#undef SG_STEP
    const int t = m0 + xrow;
#pragma unroll
    for (int g = 0; g < 4; ++g) { const int n = n0 + 32 * wn + 8 * g + 4 * hh;
        if (EPI == 0) { float* o = (float*)outp + (size_t)t * ldo + n; const f32x4 r = *(const f32x4*)(res + (size_t)t * ldo + n); f32x4 v; v.x = r.x + acc[4 * g]; v.y = r.y + acc[4 * g + 1]; v.z = r.z + acc[4 * g + 2]; v.w = r.w + acc[4 * g + 3]; *(f32x4*)o = v; }
        else if (EPI == 1) { bf16* o = (bf16*)outp + (size_t)t * ldo + n; float a0 = fmaxf(acc[4 * g], 0.f), a1 = fmaxf(acc[4 * g + 1], 0.f), a2 = fmaxf(acc[4 * g + 2], 0.f), a3 = fmaxf(acc[4 * g + 3], 0.f); v2u w; w.x = cvtpk(a0 * a0, a1 * a1); w.y = cvtpk(a2 * a2, a3 * a3); *(v2u*)o = w; }
        else { float* o = (float*)outp + (size_t)t * ldo + n; f32x4 v; v.x = acc[4 * g]; v.y = acc[4 * g + 1]; v.z = acc[4 * g + 2]; v.w = acc[4 * g + 3]; *(f32x4*)o = v; }
    }
}

__device__ __forceinline__ void p5_norm2(Frame& F) {
    for (int m = F.gw; m < R_MAIN; m += F.NGW) { f32x4 xn[4]; rms_row_to_bf16(F.out + O_Y + (size_t)m * D, F.norm2, F.XN + (size_t)m * D, F.lane, xn); }
}
__device__ __forceinline__ void p8_final(Frame& F) {
    for (int m = F.gw; m < R_MAIN; m += F.NGW) {
        GAS f32x4* xr = (GAS f32x4*)(F.out + O_Y + (size_t)m * D) + F.lane; const GAS f32x4* gr = (const GAS f32x4*)F.norm_f + F.lane;
        f32x4 v[4]; float s = 0.f;
#pragma unroll
        for (int j = 0; j < 4; ++j) { v[j] = xr[64 * j];
            if (m >= R_PROMPT) {
#pragma unroll
                for (int ks = 0; ks < 4; ++ks) v[j] += ((const GAS f32x4*)(F.SLAB + ((size_t)ks * R_SAMPLE + (m - R_PROMPT)) * D) + F.lane)[64 * j]; }
            s += (v[j].x * v[j].x + v[j].y * v[j].y) + (v[j].z * v[j].z + v[j].w * v[j].w); }
        const float r = 1.f / sqrtf(wave_sum(s) * (1.f / D) + EPS);
#pragma unroll
        for (int j = 0; j < 4; ++j) xr[64 * j] = v[j] * r * gr[64 * j];
    }
}

struct Args { const float* in[18]; float* out; unsigned char* ws; int ph_lo, ph_hi; };
__global__ void __launch_bounds__(NWAVES * 64, 2) fwd_kernel(Args args) {
    extern __shared__ __attribute__((aligned(16))) unsigned char lds[];
    Frame F;
    F.lds = (LAS unsigned char*)lds;
    F.tid = threadIdx.x; F.lane = F.tid & 63; F.wave = __builtin_amdgcn_readfirstlane(F.tid >> 6);
    F.G = gridDim.x; F.gw = blockIdx.x * NWAVES + F.wave; F.NGW = F.G * NWAVES;
    F.x_prompt = args.in[0]; F.x_sample = args.in[1]; F.state_pool = args.in[2]; F.state_C = args.in[3]; F.state_n = args.in[4]; F.state_m = args.in[5]; F.meta = args.in[6]; F.norm1 = args.in[7];
    F.w_in = args.in[8]; F.b_gate = args.in[9]; F.w_pool = args.in[10]; F.pool_scale = args.in[11]; F.head_gain = args.in[12]; F.w_out = args.in[13]; F.norm2 = args.in[14]; F.w_up = args.in[15];
    F.w_down = args.in[16]; F.norm_f = args.in[17]; F.out = args.out;
    unsigned char* ws = args.ws;
    F.Win_t = (bf16*)(ws + WS_WIN); F.Wout_t = (bf16*)(ws + WS_WOUT); F.Wup_t = (bf16*)(ws + WS_WUP); F.Wdn_t = (bf16*)(ws + WS_WDN);
    F.Gt = (float*)(ws + WS_G); F.XN = (bf16*)(ws + WS_XN); F.P = (bf16*)(ws + WS_P); F.MIX = (bf16*)(ws + WS_MIX); F.CST = (bf16*)(ws + WS_CST); F.WoRaw = (bf16*)(ws + WS_WORAW); F.NST = (float*)(ws + WS_NST); F.SCB = (float*)(ws + WS_SCB); F.SCM = (float*)(ws + WS_SCM); F.M0 = (float*)(ws + WS_M0); F.WS = (float*)(ws + WS_WSA); F.DEC = (float*)(ws + WS_DEC); F.SLAB = (float*)(ws + WS_SLAB); F.H = (bf16*)(ws + WS_H);
    for (int u = F.tid; u < (LDS_BYTES - RING_BYTES) / 4; u += NWAVES * 64) ((LAS unsigned*)(F.lds + RING_BYTES))[u] = 0u;
    __syncthreads();
    XcdBarrier bar = xcd_barrier_post((unsigned*)(ws + WS_CTL) + CW_BAR, (volatile LAS unsigned*)(F.lds + MISC_OFF) + 8);
    const int lo = args.ph_lo, hi = args.ph_hi;
#define IN(k) (lo <= (k) && (k) < hi)
#define GRID_BAR() xcd_barrier(bar)
    if (IN(0)) { p0_prologue(F); }
    if (IN(0) && IN(1)) GRID_BAR();
    if (IN(1)) { pg8::Gemm g{F.XN, F.Win_t, M_IN, NIN, D}; pg8::StaticOrder S; S.init(M_IN, NIN, F.G, (int)blockIdx.x);
        pg8::EpiIn E{F.P, P_STRIDE, 0.08838834764831845f};
        pg8::gemm_phase<pg8::EpiIn, pg8::StaticOrder, PG8_ALIGN, PG8_SP2>(F.lds, g, S, E);
        { const int first_idle = ((M_IN / 256) * (NIN / 256)) % F.G, nidle = first_idle ? F.G - first_idle : F.G, rank = first_idle ? (int)blockIdx.x - first_idle : (int)blockIdx.x;
          if (rank >= 0) { for (int bh = rank; bh < NB * NH; bh += nidle) s_scan(F, bh);
              for (int id = rank * NWAVES + F.wave; id < 512; id += nidle * NWAVES) fold_pool_tile(F, id); } } }
    if (IN(1) && IN(2)) GRID_BAR();
    if (IN(2)) { p2_state(F); }
    if (IN(2) && IN(3)) GRID_BAR();
    if (IN(3)) { p3_out(F); p3_poolstate(F); }
    if (IN(3) && IN(4)) GRID_BAR();
    if (IN(4)) { pg8::Gemm g{F.MIX, F.Wout_t, R_PROMPT, D, D}; pg8::StaticOrder S; S.init(R_PROMPT, D, F.G, (int)blockIdx.x);
        pg8::EpiRes E{F.x_prompt, F.x_sample, R_PROMPT / 256, F.out + O_Y};
        pg8::gemm_phase<pg8::EpiRes, pg8::StaticOrder, PG8_ALIGN, PG8_SP2>(F.lds, g, S, E);
        for (int tl = (int)blockIdx.x; tl < (R_SAMPLE / 64) * (D / 128); tl += F.G)
            small_gemm_tile<0>(F, F.MIX + (size_t)R_PROMPT * D, D, F.Wout_t, D, 0, D / 64, (tl >> 3) * 64, (tl & 7) * 128, F.x_sample, F.out + O_Y + (size_t)R_PROMPT * D, D); }
    if (IN(4) && IN(5)) GRID_BAR();
    if (IN(5)) { p5_norm2(F); }
    if (IN(5) && IN(6)) GRID_BAR();
    if (IN(6)) { pg8::Gemm g{F.XN, F.Wup_t, R_PROMPT, FF, D}; pg8::StaticOrder S; S.init(R_PROMPT, FF, F.G, (int)blockIdx.x);
        pg8::EpiRelu2 E{F.H, FF};
        pg8::gemm_phase<pg8::EpiRelu2, pg8::StaticOrder, PG8_ALIGN, PG8_SP2>(F.lds, g, S, E);
        for (int tl = (int)blockIdx.x; tl < (R_SAMPLE / 64) * (FF / 128); tl += F.G)
            small_gemm_tile<1>(F, F.XN + (size_t)R_PROMPT * D, D, F.Wup_t, D, 0, D / 64, (tl >> 5) * 64, (tl & 31) * 128, nullptr, F.H + (size_t)R_PROMPT * FF, FF); }
    if (IN(6) && IN(7)) GRID_BAR();
    if (IN(7)) { pg8::Gemm g{F.H, F.Wdn_t, R_PROMPT, D, FF}; pg8::StaticOrder S; S.init(R_PROMPT, D, F.G, (int)blockIdx.x);
        pg8::EpiRes E{F.out + O_Y, F.out + O_Y, 1 << 20, F.out + O_Y};
        pg8::gemm_phase<pg8::EpiRes, pg8::StaticOrder, PG8_ALIGN, PG8_SP2>(F.lds, g, S, E);
        for (int tl = (int)blockIdx.x; tl < (R_SAMPLE / 64) * (D / 128) * 4; tl += F.G) { const int ks = tl & 3, t2 = tl >> 2;
            small_gemm_tile<2>(F, F.H + (size_t)R_PROMPT * FF, FF, F.Wdn_t, FF, ks * (FF / 4), FF / 4 / 64, (t2 >> 3) * 64, (t2 & 7) * 128, nullptr, F.SLAB + (size_t)ks * R_SAMPLE * D, D); } }
    if (IN(7) && IN(8)) GRID_BAR();
    if (IN(8)) { p8_final(F); }
#undef IN
#undef GRID_BAR
}

extern "C" void kernel_launch(void* const* d_in, const int* in_sizes, int n_in, void* d_out, int out_size, void* d_ws, size_t ws_size, hipStream_t stream) {
    static int grid = 0;
    if (grid == 0) {
        if (n_in != 18 || out_size != (int)O_END || ws_size < WS_END) { fprintf(stderr, "kernel_launch: unexpected shapes n_in %d out %d ws %zu\n", n_in, out_size, ws_size); grid = -1; return; }
        int dev = 0, cus = 0;
        if (hipGetDevice(&dev) != hipSuccess || hipDeviceGetAttribute(&cus, hipDeviceAttributeMultiprocessorCount, dev) != hipSuccess) { grid = -1; return; }
        if (hipFuncSetAttribute((const void*)fwd_kernel, hipFuncAttributeMaxDynamicSharedMemorySize, LDS_BYTES) != hipSuccess) { fprintf(stderr, "kernel_launch: hipFuncSetAttribute failed\n"); grid = -1; return; }
        grid = cus;
    }
    if (grid < 0) return;
    Args a{};
    for (int i = 0; i < 18; ++i) a.in[i] = (const float*)d_in[i];
    a.out = (float*)d_out; a.ws = (unsigned char*)d_ws;
    if (hipMemsetAsync((char*)d_ws + WS_CTL, 0, CTL_ZERO_BYTES, stream) != hipSuccess) { fprintf(stderr, "kernel_launch: memset failed\n"); return; }
    a.ph_lo = 0; a.ph_hi = 9; hipLaunchKernelGGL(fwd_kernel, dim3(grid), dim3(NWAVES * 64), LDS_BYTES, stream, a);
}
```

```cpp
#include <hip/hip_runtime.h>
#include <cstdio>
#include <cstdint>
namespace pg8 {
#define PG8_LAS __attribute__((address_space(3)))
typedef unsigned short bf16_t;
typedef short bf16x8 __attribute__((ext_vector_type(8)));
typedef float f32x4 __attribute__((ext_vector_type(4)));
typedef unsigned u32x4 __attribute__((ext_vector_type(4)));
constexpr int BM = 256, BK = 64, HALF = 128, HTB = HALF * BK * 2  , STAGE_BYTES = 8 * HTB, NXCD = 8, WGM = 8;

__host__ __device__ __forceinline__ int lds_byte(int r, int c) { const int st = (r >> 4) * 2 + (c >> 5), rr = r & 15, cc = c & 31, ob = rr * 64 + cc * 2; return st * 1024 + (ob ^ (((ob >> 9) & 1) << 5)); }
__host__ __device__ __forceinline__ void stage_rc(int b, int& R, int& C) { const int st = b / 1024, sb = b % 1024, swz = sb ^ (((sb >> 9) & 1) << 5); R = (st >> 1) * 16 + swz / 64; C = (st & 1) * 32 + (swz % 64) / 2; }
__host__ __device__ __forceinline__ int perm32(int rho) { const int n = rho >> 4, i = rho & 15; return 8 * (i >> 2) + 4 * n + (i & 3); }

struct Unit { int pm, pn; };
struct Gemm { const bf16_t* A; const bf16_t* Bt; int M, N, K; };

struct StaticOrder {
    int nM, nN, nwg, G, c;
    __host__ __device__ void init(int M, int N, int G_, int c_) { nM = M / BM; nN = N / BM; nwg = nM * nN; G = G_; c = c_; }
    __host__ __device__ bool next(int i, Unit& u) const {
        const long L = (long)i * G + c; if (L >= nwg) return false;
        int wgid = (int)L; { const int q = nwg / NXCD, r = nwg % NXCD, xcd = wgid % NXCD, off = wgid / NXCD; wgid = (xcd < r ? xcd * (q + 1) : r * (q + 1) + (xcd - r) * q) + off; }
        const int nig = WGM * nN, gid = wgid / nig, fm = gid * WGM, gsz = (nM - fm) < WGM ? (nM - fm) : WGM;
        u.pm = fm + ((wgid % nig) % gsz); u.pn = (wgid % nig) / gsz; return true;
    }
    __device__ __forceinline__ void a_ready(const Unit&) const {}
    __device__ __forceinline__ void done(const Unit&) const {}
};

__device__ __forceinline__ unsigned cvt_pk_bf16(float lo, float hi) { unsigned r; asm volatile("v_cvt_pk_bf16_f32 %0, %1, %2" : "=v"(r) : "v"(lo), "v"(hi)); return r; }

struct EpiIn {
    static constexpr bool PERM = true, AFTER_DRAIN = false;
    bf16_t* O; size_t split_stride; float qscale;
    __device__ __forceinline__ void operator()(const f32x4 (&acc)[2][2][4][2], const Unit& u, int wr, int wc, int fr, int fq) const {
        const int row0 = u.pm * BM + wr * 64 + fr; const int t = u.pn >> 1; const int colt = (u.pn & 1) * BM;
        bf16_t* base = O + (size_t)t * split_stride; const float sc = (t == 1) ? qscale : 1.f;
        const int col0 = colt + wc * 32 + 8 * fq;
#pragma unroll
        for (int ai = 0; ai < 2; ++ai)
#pragma unroll
            for (int m = 0; m < 4; ++m) { bf16_t* rowp = base + (size_t)(row0 + ai * HALF + m * 16) * 512 + col0;
#pragma unroll
                for (int bj = 0; bj < 2; ++bj) { f32x4 v0 = acc[ai][bj][m][0] * sc, v1 = acc[ai][bj][m][1] * sc;
                    u32x4 w; w.x = cvt_pk_bf16(v0[0], v0[1]); w.y = cvt_pk_bf16(v0[2], v0[3]); w.z = cvt_pk_bf16(v1[0], v1[1]); w.w = cvt_pk_bf16(v1[2], v1[3]);
                    *(u32x4*)(rowp + bj * HALF) = w; } }
    }
};
struct EpiRelu2 {
    static constexpr bool PERM = true, AFTER_DRAIN = false;
    bf16_t* O; int ldc;
    __device__ __forceinline__ void operator()(const f32x4 (&acc)[2][2][4][2], const Unit& u, int wr, int wc, int fr, int fq) const {
        const int row0 = u.pm * BM + wr * 64 + fr; const int col0 = u.pn * BM + wc * 32 + 8 * fq;
#pragma unroll
        for (int ai = 0; ai < 2; ++ai)
#pragma unroll
            for (int m = 0; m < 4; ++m) { bf16_t* rowp = O + (size_t)(row0 + ai * HALF + m * 16) * ldc + col0;
#pragma unroll
                for (int bj = 0; bj < 2; ++bj) { f32x4 v0 = acc[ai][bj][m][0], v1 = acc[ai][bj][m][1];
#pragma unroll
                    for (int e = 0; e < 4; ++e) { const float a = fmaxf(v0[e], 0.f), b = fmaxf(v1[e], 0.f); v0[e] = a * a; v1[e] = b * b; }
                    u32x4 w; w.x = cvt_pk_bf16(v0[0], v0[1]); w.y = cvt_pk_bf16(v0[2], v0[3]); w.z = cvt_pk_bf16(v1[0], v1[1]); w.w = cvt_pk_bf16(v1[2], v1[3]);
                    *(u32x4*)(rowp + bj * HALF) = w; } }
    }
};
struct EpiRes {
    static constexpr bool PERM = false, AFTER_DRAIN = false;
    const float* resA; const float* resB; int split_pm; float* out;
    __device__ __forceinline__ void operator()(const f32x4 (&acc)[2][2][4][2], const Unit& u, int wr, int wc, int fr, int fq) const {
        const int row0 = u.pm * BM + wr * 64 + fr, col0 = u.pn * BM + wc * 32 + 4 * fq;
        const float* res = (u.pm < split_pm) ? resA : (resB - (size_t)split_pm * BM * 1024);
#pragma unroll
        for (int ai = 0; ai < 2; ++ai)
#pragma unroll
            for (int m = 0; m < 4; ++m) { const size_t off = (size_t)(row0 + ai * HALF + m * 16) * 1024 + col0;
#pragma unroll
                for (int bj = 0; bj < 2; ++bj)
#pragma unroll
                    for (int n = 0; n < 2; ++n) { const f32x4 r = *(const f32x4*)(res + off + bj * HALF + n * 16); *(f32x4*)(out + off + bj * HALF + n * 16) = r + acc[ai][bj][m][n]; } }
    }
};

template <class Epi, class Sched, bool ALIGN_EPI = false, bool SP2 = false>
__device__ __forceinline__ void gemm_phase(PG8_LAS unsigned char* lds, const Gemm g, const Sched& S, const Epi& E) {
    const int tid = threadIdx.x, wid = __builtin_amdgcn_readfirstlane(tid >> 6), lane = tid & 63, wr = wid >> 2, wc = wid & 3, fr = lane & 15, fq = lane >> 4;
    const int K = g.K, nt = K / BK;
    unsigned voffA[2], voffB[2];
#pragma unroll
    for (int i = 0; i < 2; ++i) { int R, C; stage_rc(tid * 16 + i * 8192, R, C); const int Rb = Epi::PERM ? ((R & ~31) + perm32(R & 31)) : R;
        voffA[i] = (unsigned)(R * K + C) * 2u; voffB[i] = (unsigned)(Rb * K + C) * 2u; }
    const size_t kstep = (size_t)(BK * 2);
    const size_t hstep = (size_t)HALF * K * 2;
    const size_t tstep = 2 * hstep;
    const unsigned ldsw = (unsigned)wid * 1024u;
    const int aoff = lds_byte(wr * 64 + fr, fq * 8), boff = lds_byte(wc * 32 + fr, fq * 8);
#define PG8_SA(b, h) (((b) * 2 + (h)) * HTB)
#define PG8_SB(b, h) ((4 + (b) * 2 + (h)) * HTB)
#define PG8_STAGE(bufoff, gbase, voff) do { _Pragma("unroll") for (int _i = 0; _i < 2; ++_i) \
        __builtin_amdgcn_global_load_lds((const unsigned*)((const char*)(gbase) + (voff)[_i]), (PG8_LAS unsigned*)(lds + (bufoff) + ldsw + _i * 8192), 16, 0, 0); } while (0)
#define PG8_LDA(dst, b, h) do { _Pragma("unroll") for (int m = 0; m < 4; ++m) _Pragma("unroll") for (int k = 0; k < 2; ++k) dst[m][k] = *(const PG8_LAS bf16x8*)(lds + PG8_SA(b, h) + aoff + m * 2048 + k * 1024); } while (0)
#define PG8_LDB(dst, b, h) do { _Pragma("unroll") for (int n = 0; n < 2; ++n) _Pragma("unroll") for (int k = 0; k < 2; ++k) dst[n][k] = *(const PG8_LAS bf16x8*)(lds + PG8_SB(b, h) + boff + n * 2048 + k * 1024); } while (0)
#define PG8_MMA(ai, bj, At, Bt) do { __builtin_amdgcn_s_setprio(1); _Pragma("unroll") for (int m = 0; m < 4; ++m) _Pragma("unroll") for (int n = 0; n < 2; ++n) _Pragma("unroll") for (int k = 0; k < 2; ++k) \
        acc[ai][bj][m][n] = __builtin_amdgcn_mfma_f32_16x16x32_bf16(Bt[n][k], At[m][k], acc[ai][bj][m][n], 0, 0, 0); __builtin_amdgcn_s_setprio(0); } while (0)
#define PG8_WAIT_V(n) asm volatile("s_waitcnt vmcnt(" #n ")" ::: "memory")
#define PG8_WAIT_L(n) asm volatile("s_waitcnt lgkmcnt(" #n ")" ::: "memory")
#define PG8_BAR __builtin_amdgcn_s_barrier()
#define PG8_SCHED __builtin_amdgcn_sched_barrier(0)
    Unit cur, nxt; int ui = 0;
    if (!S.next(0, cur)) return;
    f32x4 acc[2][2][4][2];
#pragma unroll
    for (int a = 0; a < 2; ++a)
#pragma unroll
        for (int b = 0; b < 2; ++b)
#pragma unroll
            for (int m = 0; m < 4; ++m)
#pragma unroll
                for (int n = 0; n < 2; ++n) acc[a][b][m][n] = (f32x4){0.f, 0.f, 0.f, 0.f};
    bf16x8 At[4][2], B0[2][2], B1[2][2];
    const char* cA = (const char*)g.A + (size_t)cur.pm * tstep; const char* cB = (const char*)g.Bt + (size_t)cur.pn * tstep;
    S.a_ready(cur);
    if constexpr (SP2) {
        PG8_STAGE(PG8_SB(0, 0), cB, voffB); PG8_STAGE(PG8_SB(0, 1), cB + hstep, voffB); PG8_STAGE(PG8_SA(0, 0), cA, voffA); PG8_STAGE(PG8_SA(0, 1), cA + hstep, voffA);
        if (wr == 1) PG8_BAR;
        PG8_WAIT_V(2); PG8_BAR;
        PG8_STAGE(PG8_SB(1, 0), cB + kstep, voffB); PG8_STAGE(PG8_SA(1, 0), cA + kstep, voffA); PG8_STAGE(PG8_SB(1, 1), cB + hstep + kstep, voffB);
        PG8_WAIT_V(6); PG8_BAR;
    } else {
        PG8_STAGE(PG8_SB(0, 0), cB, voffB); PG8_STAGE(PG8_SA(0, 0), cA, voffA); PG8_STAGE(PG8_SB(0, 1), cB + hstep, voffB); PG8_STAGE(PG8_SA(0, 1), cA + hstep, voffA);
        if (wr == 1) PG8_BAR;
        PG8_WAIT_V(4); PG8_BAR;
        PG8_STAGE(PG8_SB(1, 0), cB + kstep, voffB); PG8_STAGE(PG8_SA(1, 0), cA + kstep, voffA); PG8_STAGE(PG8_SB(1, 1), cB + hstep + kstep, voffB);
        PG8_WAIT_V(6); PG8_BAR;
    }
    for (;;) {
        const bool has_next = S.next(ui + 1, nxt);
        const char* nA = has_next ? (const char*)g.A + (size_t)nxt.pm * tstep : cA; const char* nB = has_next ? (const char*)g.Bt + (size_t)nxt.pn * tstep : cB;
        for (int t = 0; t < nt; t += 2) {
            const bool last = (t == nt - 2);
            const char* a1 = cA + (size_t)(t + 1) * kstep;
            const char* a2 = last ? nA : cA + (size_t)(t + 2) * kstep; const char* b2 = last ? nB : cB + (size_t)(t + 2) * kstep;
            const char* a3 = a2 + kstep; const char* b3 = b2 + kstep;
            if (last && has_next) S.a_ready(nxt);
            if constexpr (SP2) {
            PG8_LDB(B0, 0, 0); PG8_LDB(B1, 0, 1); PG8_SCHED; PG8_LDA(At, 0, 0); PG8_STAGE(PG8_SA(1, 1), a1 + hstep, voffA);
            PG8_WAIT_V(8); PG8_WAIT_L(0); PG8_BAR; PG8_MMA(0, 0, At, B0); PG8_MMA(0, 1, At, B1); PG8_BAR; PG8_SCHED;
            PG8_LDA(At, 0, 1); PG8_STAGE(PG8_SB(0, 0), b2, voffB); PG8_STAGE(PG8_SB(0, 1), b2 + hstep, voffB); PG8_STAGE(PG8_SA(0, 0), a2, voffA);
            PG8_WAIT_V(8); PG8_WAIT_L(0); PG8_BAR; PG8_MMA(1, 0, At, B0); PG8_MMA(1, 1, At, B1); PG8_BAR; PG8_SCHED;
            PG8_LDB(B0, 1, 0); PG8_LDB(B1, 1, 1); PG8_SCHED; PG8_LDA(At, 1, 0); PG8_STAGE(PG8_SA(0, 1), a2 + hstep, voffA);
            PG8_WAIT_V(8); PG8_WAIT_L(0); PG8_BAR; PG8_MMA(0, 0, At, B0); PG8_MMA(0, 1, At, B1); PG8_BAR; PG8_SCHED;
            PG8_LDA(At, 1, 1); PG8_STAGE(PG8_SB(1, 0), b3, voffB); PG8_STAGE(PG8_SB(1, 1), b3 + hstep, voffB); PG8_STAGE(PG8_SA(1, 0), a3, voffA);
            PG8_WAIT_V(8); PG8_WAIT_L(0); PG8_BAR; PG8_MMA(1, 0, At, B0); PG8_MMA(1, 1, At, B1); PG8_BAR; PG8_SCHED;
            } else {
            PG8_LDB(B0, 0, 0); PG8_SCHED; PG8_LDA(At, 0, 0); PG8_STAGE(PG8_SA(1, 1), a1 + hstep, voffA);
            PG8_WAIT_L(8); PG8_BAR; PG8_WAIT_L(0); PG8_MMA(0, 0, At, B0); PG8_BAR; PG8_SCHED;
            PG8_LDB(B1, 0, 1); PG8_STAGE(PG8_SB(0, 0), b2, voffB);
            PG8_BAR; PG8_WAIT_L(0); PG8_MMA(0, 1, At, B1); PG8_BAR;
            PG8_LDA(At, 0, 1); PG8_STAGE(PG8_SA(0, 0), a2, voffA);
            PG8_BAR; PG8_WAIT_L(0); PG8_MMA(1, 0, At, B0); PG8_BAR; PG8_SCHED;
            PG8_STAGE(PG8_SB(0, 1), b2 + hstep, voffB);
            PG8_WAIT_V(6); PG8_BAR; PG8_MMA(1, 1, At, B1); PG8_BAR;
            PG8_LDB(B0, 1, 0); PG8_SCHED; PG8_LDA(At, 1, 0); PG8_STAGE(PG8_SA(0, 1), a2 + hstep, voffA);
            PG8_WAIT_L(8); PG8_BAR; PG8_WAIT_L(0); PG8_MMA(0, 0, At, B0); PG8_BAR; PG8_SCHED;
            PG8_LDB(B1, 1, 1); PG8_STAGE(PG8_SB(1, 0), b3, voffB);
            PG8_BAR; PG8_WAIT_L(0); PG8_MMA(0, 1, At, B1); PG8_BAR;
            PG8_LDA(At, 1, 1); PG8_STAGE(PG8_SA(1, 0), a3, voffA);
            PG8_BAR; PG8_WAIT_L(0); PG8_MMA(1, 0, At, B0); PG8_BAR; PG8_SCHED;
            PG8_STAGE(PG8_SB(1, 1), b3 + hstep, voffB);
            PG8_WAIT_V(6); PG8_BAR; PG8_MMA(1, 1, At, B1); PG8_BAR;
            }
        }
        if constexpr (ALIGN_EPI) { if (wr == 0) PG8_BAR; }
        if constexpr (!Epi::AFTER_DRAIN) { E(acc, cur, wr, wc, fr, fq); S.done(cur); }
        if (!has_next) break;
#pragma unroll
        for (int a = 0; a < 2; ++a)
#pragma unroll
            for (int b = 0; b < 2; ++b)
#pragma unroll
                for (int m = 0; m < 4; ++m)
#pragma unroll
                    for (int n = 0; n < 2; ++n) acc[a][b][m][n] = (f32x4){0.f, 0.f, 0.f, 0.f};
        cur = nxt; cA = nA; cB = nB; ++ui;
        if constexpr (ALIGN_EPI) { if (wr == 1) PG8_BAR; }
    }
    PG8_WAIT_V(0);
    if constexpr (!ALIGN_EPI) { if (wr == 0) PG8_BAR; }
    PG8_BAR;
    if constexpr (Epi::AFTER_DRAIN) { E.fused(acc, cur, wr, wc, fr, fq, lds, wid, lane); S.done(cur); }
#undef PG8_SA
#undef PG8_SB
#undef PG8_STAGE
#undef PG8_LDA
#undef PG8_LDB
#undef PG8_MMA
#undef PG8_WAIT_V
#undef PG8_WAIT_L
#undef PG8_BAR
#undef PG8_SCHED
}
}
#ifndef PG8_SP2
#define PG8_SP2 true
#endif
#ifndef PG8_ALIGN
#define PG8_ALIGN true
#endif
constexpr int NWAVES = 8;
constexpr int D = 1024, NB = 8, SEQ = 2048, DECB = 128, DECT = 4, NMETA = 16;
constexpr int PW = 512, NH = 4, HD = 128, FF = 4096, INC = 2568, NIN = 2560;
constexpr int R_PROMPT = NB * SEQ;
constexpr int R_SAMPLE = DECB * DECT;
constexpr int R_MAIN = R_PROMPT + R_SAMPLE;
constexpr int R_META0 = R_MAIN;
constexpr int R_IN = R_MAIN + NMETA;
constexpr int M_IN = 17152;
constexpr int LP = SEQ + NMETA;
constexpr float EPS = 1e-6f;
constexpr size_t MiB = 1u << 20;
constexpr size_t WS_CTL = 0, CTL_ZERO_BYTES = 1 * MiB;
constexpr int CW_BAR = 4096;
constexpr size_t WS_WIN = 1 * MiB, WS_WOUT = 6 * MiB, WS_WUP = 8 * MiB, WS_WDN = 16 * MiB;
constexpr size_t WS_G = 24 * MiB;
constexpr size_t WS_XN = 25 * MiB;
constexpr size_t WS_P = 59 * MiB;
constexpr size_t P_STRIDE = (size_t)M_IN * 512;
constexpr size_t WS_MIX = 143 * MiB;
constexpr size_t WS_CST = 176 * MiB;
constexpr size_t WS_NST = 208 * MiB;
constexpr size_t WS_SCB = 208 * MiB + 512 * 1024;
constexpr size_t WS_SCM = WS_SCB + 288 * 1024;
constexpr size_t WS_M0 = WS_SCM + 288 * 1024;
constexpr size_t WS_WSA = WS_M0 + 8 * 1024;
constexpr size_t WS_DEC = WS_WSA + 288 * 1024;
constexpr size_t WS_WORAW = WS_DEC + 8 * 1024;
constexpr size_t WS_H = 59 * MiB;
constexpr size_t WS_SLAB = 212 * MiB;
constexpr size_t WS_END = 220 * MiB;
static_assert(WS_P + 5 * P_STRIDE * 2 <= WS_MIX && WS_MIX + (size_t)R_MAIN * 1024 * 2 <= WS_CST && WS_WORAW + 1024 * 512 * 2 <= WS_END && WS_H + (size_t)R_MAIN * FF * 2 <= WS_END, "d_ws map");
constexpr size_t O_Y = 0, O_POOLP = 17301504, O_CP = 17362944, O_NP = 17887232, O_MP = 17891328, O_POOLS = 17891360, O_CS = 18874400, O_NS = 27263008, O_MS = 27328544, O_END = 27329056;
constexpr int RING_BYTES = 131072, LDS_BYTES = 147456, MISC_OFF = RING_BYTES + 320;

#define GAS __attribute__((address_space(1)))
#define LAS __attribute__((address_space(3)))
typedef unsigned short bf16;
typedef unsigned v4u __attribute__((ext_vector_type(4)));
typedef unsigned v2u __attribute__((ext_vector_type(2)));
typedef float f32x4 __attribute__((ext_vector_type(4)));
typedef float f32x2 __attribute__((ext_vector_type(2)));
#define LDS_WAIT() asm volatile("s_waitcnt lgkmcnt(0)" ::: "memory")
#define VM_WAIT() asm volatile("s_waitcnt vmcnt(0)" ::: "memory")
__device__ __forceinline__ unsigned f2bf(float f) { unsigned u = __builtin_bit_cast(unsigned, f); return (u + 0x7fffu + ((u >> 16) & 1u)) >> 16; }
__device__ __forceinline__ unsigned pk2(float lo, float hi) { return f2bf(lo) | (f2bf(hi) << 16); }
__device__ __forceinline__ float bf2f(unsigned short b) { return __builtin_bit_cast(float, (unsigned)b << 16); }
__device__ __forceinline__ float bflo(unsigned w) { return __builtin_bit_cast(float, w << 16); }
__device__ __forceinline__ float bfhi(unsigned w) { return __builtin_bit_cast(float, w & 0xffff0000u); }
__device__ __forceinline__ float wave_sum(float v) {
#pragma unroll
    for (int o = 1; o < 64; o <<= 1) v += __shfl_xor(v, o);
    return v;
}
__device__ __forceinline__ float sigmoidf_(float x) { return __builtin_amdgcn_rcpf(1.f + __expf(-x)); }
__device__ __forceinline__ float logsigmoidf_(float x) { return fminf(x, 0.f) - log1pf(expf(-fabsf(x))); }

#define XB_TMO      128
#define XB_XCNT(j)  (256  + 64 * (j))
#define XB_XSUB(j)  (1280 + 64 * (j))
#define XB_XGEN(j)  (2304 + 64 * (j))
#define XB_TOP      3328
#define XB_TOPGEN   3392
#define XCD_BAR_WORDS 3456
#define XB_SPIN_CAP (1u << 18)

__device__ __forceinline__ unsigned xb_ld(unsigned* p)              { return __hip_atomic_load(p, __ATOMIC_RELAXED, __HIP_MEMORY_SCOPE_AGENT); }
__device__ __forceinline__ unsigned xb_add(unsigned* p, unsigned v) { return __hip_atomic_fetch_add(p, v, __ATOMIC_RELAXED, __HIP_MEMORY_SCOPE_AGENT); }
__device__ __forceinline__ unsigned xb_xcc_id() { return (unsigned)__builtin_amdgcn_s_getreg((3 << 11) | 20) & 0xFu; }
#define XB_SPIN(cond, bar) do { unsigned _sp = 0; while (cond) { __builtin_amdgcn_s_sleep(1); \
    if ((++_sp & 255u) == 0u) { if (xb_ld(&(bar)[XB_TMO])) break; if (_sp > XB_SPIN_CAP) { atomicAdd(&(bar)[XB_TMO], 1u); break; } } } } while (0)

struct XcdBarrier {
    unsigned* bar; unsigned x;
    volatile LAS unsigned* st;
};

__device__ __forceinline__ XcdBarrier xcd_barrier_post(unsigned* bar, volatile LAS unsigned* st) {
    XcdBarrier b; b.bar = bar; b.x = xb_xcc_id(); b.st = st;
    if (threadIdx.x == 0) (void)xb_add(&bar[XB_XCNT(b.x)], 1u);
    return b;
}
__device__ __forceinline__ void xcd_barrier_complete(unsigned* bar, unsigned x, unsigned& nloc, unsigned& nx) {
    const unsigned G = gridDim.x * gridDim.y * gridDim.z;
    unsigned sum, cnt, mine, sp = 0u;
    for (;;) {
        sum = 0u; cnt = 0u; mine = 0u;
#pragma unroll
        for (unsigned j = 0; j < 16; ++j) { const unsigned c = xb_ld(&bar[XB_XCNT(j)]); sum += c; cnt += (c > 0u) ? 1u : 0u; mine = (j == x) ? c : mine; }
        if (sum == G) break;
        __builtin_amdgcn_s_sleep(1);
        if ((++sp & 255u) == 0u) { if (xb_ld(&bar[XB_TMO])) break; if (sp > XB_SPIN_CAP) { atomicAdd(&bar[XB_TMO], 1u); break; } }
    }
    nloc = mine > 0u ? mine : 1u; nx = cnt > 0u ? cnt : 1u;
}

__device__ __forceinline__ void xcd_barrier(const XcdBarrier& b) {
    asm volatile("s_waitcnt vmcnt(0)" ::: "memory");
    __syncthreads();
    if (threadIdx.x == 0) {
        unsigned* bar = b.bar;
        __builtin_amdgcn_s_waitcnt(0);
        unsigned nloc = b.st[0], nx = b.st[1];
        if (nloc == 0u) { xcd_barrier_complete(bar, b.x, nloc, nx); b.st[0] = nloc; b.st[1] = nx; }
        const unsigned old = xb_add(&bar[XB_XSUB(b.x)], 1u);
        const unsigned gen = old / nloc;
        if (old + 1u == (gen + 1u) * nloc) {
            __builtin_amdgcn_fence(__ATOMIC_RELEASE, "agent");
            asm volatile("s_waitcnt vmcnt(0)" ::: "memory");
            const unsigned og = xb_add(&bar[XB_TOP], 1u);
            const unsigned tg = og / nx;
            if (og + 1u == (tg + 1u) * nx) xb_add(&bar[XB_TOPGEN], 1u);
            else XB_SPIN(xb_ld(&bar[XB_TOPGEN]) == tg, bar);
            __builtin_amdgcn_fence(__ATOMIC_ACQUIRE, "agent");
            xb_add(&bar[XB_XGEN(b.x)], 1u);
            asm volatile("s_waitcnt vmcnt(0)" ::: "memory");
        } else {
            XB_SPIN(xb_ld(&bar[XB_XGEN(b.x)]) == gen, bar);
            __builtin_amdgcn_fence(__ATOMIC_ACQUIRE, "agent");
            asm volatile("s_waitcnt vmcnt(0)" ::: "memory");
        }
    }
    __syncthreads();
}

struct Frame {
    LAS unsigned char* lds;
    int tid, lane, wave, G, gw, NGW;
    const float *x_prompt, *x_sample, *state_pool, *state_C, *state_n, *state_m, *meta, *norm1, *w_in, *b_gate, *w_pool, *pool_scale, *head_gain, *w_out, *norm2, *w_up, *w_down, *norm_f;
    float* out;
    bf16 *Win_t, *Wout_t, *Wup_t, *Wdn_t, *XN, *P, *MIX, *H;
    float *Gt, *NST, *SCB, *SCM, *M0, *WS, *DEC, *SLAB;
    bf16 *CST, *WoRaw;
};

__device__ __forceinline__ void p0_transpose_item(const float* W, int ldw, int ncols, bf16* WT, int ldt, const float* rowscale, LAS float* scr, int item, int lane) {
    const int nblk = ncols / 32, kb = item / nblk, nb = item % nblk, k0 = 64 * kb, n0 = 32 * nb;
#pragma unroll 8
    for (int i = 0; i < 32; ++i) { const int kk = 2 * i + (lane >> 5); float w = W[(size_t)(k0 + kk) * ldw + n0 + (lane & 31)]; if (rowscale) w *= rowscale[k0 + kk]; scr[kk * 33 + (lane & 31)] = w; }
    LDS_WAIT(); asm volatile("" ::: "memory");
    const int c = lane & 7;
#pragma unroll
    for (int j = 0; j < 4; ++j) { const int n = (lane >> 3) + 8 * j; const LAS float* s = scr + (8 * c) * 33 + n;
        v4u o; o.x = pk2(s[0 * 33], s[1 * 33]); o.y = pk2(s[2 * 33], s[3 * 33]); o.z = pk2(s[4 * 33], s[5 * 33]); o.w = pk2(s[6 * 33], s[7 * 33]);
        *(GAS v4u*)(WT + (size_t)(n0 + n) * ldt + k0 + 8 * c) = o; }
    LDS_WAIT(); asm volatile("" ::: "memory");
}
__device__ __forceinline__ const float* in_row_ptr(const Frame& F, int r) {
    return r < R_PROMPT ? F.x_prompt + (size_t)r * D : (r < R_MAIN ? F.x_sample + (size_t)(r - R_PROMPT) * D : F.meta + (size_t)(r - R_META0) * D);
}
__device__ __forceinline__ void rms_row_to_bf16(const float* xrow, const float* g, bf16* orow, int lane, f32x4 (&xn)[4]) {
    const GAS f32x4* xr = (const GAS f32x4*)xrow + lane; const GAS f32x4* gr = (const GAS f32x4*)g + lane;
    float s = 0.f;
#pragma unroll
    for (int j = 0; j < 4; ++j) { xn[j] = xr[64 * j]; s += (xn[j].x * xn[j].x + xn[j].y * xn[j].y) + (xn[j].z * xn[j].z + xn[j].w * xn[j].w); }
    const float r = 1.f / sqrtf(wave_sum(s) * (1.f / D) + EPS);
    GAS v2u* o8 = (GAS v2u*)orow + lane;
#pragma unroll
    for (int j = 0; j < 4; ++j) { xn[j] = xn[j] * r * gr[64 * j]; v2u w; w.x = pk2(xn[j].x, xn[j].y); w.y = pk2(xn[j].z, xn[j].w); o8[64 * j] = w; }
}
__device__ __forceinline__ void p0_prologue(Frame& F) {
    LAS float* scr = (LAS float*)(F.lds + F.wave * 8448);
    LAS float* wgL = (LAS float*)(F.lds + 69632);
    for (int e = F.tid; e < 8 * D; e += NWAVES * 64) { const int g = e >> 10, k = e & 1023; wgL[e] = F.w_in[(size_t)k * INC + NIN + g]; }
    constexpr int I_IN = (D / 64) * (NIN / 32), I_OT = (PW / 64) * (D / 32), I_OB = I_OT, I_UP = (D / 64) * (FF / 32), I_DN = (FF / 64) * (D / 32);
    constexpr int NITEMS = I_IN + I_OT + I_OB + I_UP + I_DN;
    for (int it = F.gw; it < NITEMS; it += F.NGW) {
        int r = it;
        if (r < I_IN) { p0_transpose_item(F.w_in, INC, NIN, F.Win_t, D, nullptr, scr, r, F.lane); continue; } r -= I_IN;
        if (r < I_OT) { p0_transpose_item(F.w_out, D, D, F.WoRaw, PW, nullptr, scr, r, F.lane); continue; } r -= I_OT;
        if (r < I_OB) { p0_transpose_item(F.w_out + (size_t)PW * D, D, D, F.Wout_t + PW, D, F.head_gain, scr, r, F.lane); continue; } r -= I_OB;
        if (r < I_UP) { p0_transpose_item(F.w_up, FF, FF, F.Wup_t, D, nullptr, scr, r, F.lane); continue; } r -= I_UP;
        p0_transpose_item(F.w_down, D, D, F.Wdn_t, FF, nullptr, scr, r, F.lane);
    }
    __syncthreads();
    for (int m = F.gw; m < M_IN; m += F.NGW) {
        bf16* orow = F.XN + (size_t)m * D;
        if (m >= R_IN) { GAS v2u* o8 = (GAS v2u*)orow + F.lane; v2u z; z.x = 0u; z.y = 0u;
#pragma unroll
            for (int j = 0; j < 4; ++j) o8[64 * j] = z;
            if (F.lane < 8) F.Gt[(size_t)m * 8 + F.lane] = 0.f;
            continue; }
        f32x4 xn[4];
        rms_row_to_bf16(in_row_ptr(F, m), F.norm1, orow, F.lane, xn);
        float gs[8];
#pragma unroll
        for (int g = 0; g < 8; ++g) { float s = 0.f;
#pragma unroll
            for (int j = 0; j < 4; ++j) { const f32x4 w = *(const LAS f32x4*)(wgL + g * D + 4 * F.lane + 256 * j); s += (xn[j].x * w.x + xn[j].y * w.y) + (xn[j].z * w.z + xn[j].w * w.w); }
            gs[g] = wave_sum(s); }
        float val = gs[0];
#pragma unroll
        for (int g = 1; g < 8; ++g) val = (F.lane == g) ? gs[g] : val;
        if (F.lane < 8) { val += F.b_gate[F.lane]; F.Gt[(size_t)m * 8 + F.lane] = (F.lane < 4) ? val : logsigmoidf_(val); }
    }
}

typedef short bf16x8 __attribute__((ext_vector_type(8)));
typedef short s16x4 __attribute__((ext_vector_type(4)));
typedef float f32x16 __attribute__((ext_vector_type(16)));
#define MFMA32(a, b, c) __builtin_amdgcn_mfma_f32_32x32x16_bf16((a), (b), (c), 0, 0, 0)
__device__ __forceinline__ s16x4 vtr(const LAS unsigned char* p) { return __builtin_bit_cast(s16x4, __builtin_amdgcn_ds_read_tr16_b64_v4i16((LAS s16x4*)p)); }
__device__ __forceinline__ bf16x8 cat8(s16x4 lo, s16x4 hi) { return __builtin_shufflevector(lo, hi, 0, 1, 2, 3, 4, 5, 6, 7); }
__device__ __forceinline__ unsigned cvtpk(float lo, float hi) { typedef __bf16 bf16x2_t __attribute__((ext_vector_type(2))); f32x2 v = {lo, hi}; bf16x2_t b = __builtin_convertvector(v, bf16x2_t); return __builtin_bit_cast(unsigned, b); }
constexpr int IMG_STRIDE = 320;
constexpr int IMG_BYTES = 64 * IMG_STRIDE;
__device__ __forceinline__ int chunk_T(int c) { return c ? 64 : 16; }
__device__ __forceinline__ int chunk_p0(int c) { return c ? NMETA + (c - 1) * 64 : 0; }
__device__ __forceinline__ int chunk_row0(int b, int c) { return c ? b * SEQ + (c - 1) * 64 : R_META0; }

__device__ __forceinline__ void s_scan(Frame& F, int bh) {
    const int b = bh >> 2, h = bh & 3, tid = F.tid, lane = F.lane, wave = F.wave;
    LAS float* sb = (LAS float*)F.lds; LAS float* sg = sb + 2080; LAS float* sig = sg + 2080; LAS float* sB = sig + 2080; LAS float* sMl = sB + 40; LAS float* sm0 = sMl + 40;
    for (int c = wave; c < 33; c += NWAVES) {
        const int T = chunk_T(c), p0 = chunk_p0(c), row0 = chunk_row0(b, c);
        float lf = 0.f, ig = -INFINITY;
        if (lane < T) { lf = F.Gt[(size_t)(row0 + lane) * 8 + 4 + h]; ig = F.Gt[(size_t)(row0 + lane) * 8 + h]; }
        float bs = lf;
#pragma unroll
        for (int o = 1; o < 64; o <<= 1) { const float t = __shfl_up(bs, o); if (lane >= o) bs += t; }
        float g = ig - bs;
#pragma unroll
        for (int o = 1; o < 64; o <<= 1) { const float t = __shfl_up(g, o); if (lane >= o) g = fmaxf(g, t); }
        if (lane < T) { sb[p0 + lane] = bs; sg[p0 + lane] = g; sig[p0 + lane] = ig; }
        const float Bc = __shfl(bs, T - 1), gl = __shfl(g, T - 1);
        if (lane == 0) { sB[c] = Bc; sMl[c] = Bc + gl; }
    }
    __syncthreads();
    if (tid == 0) { float m = 0.f; sm0[0] = 0.f; for (int c = 0; c < 33; ++c) { m = fmaxf(m + sB[c], sMl[c]); sm0[c + 1] = m; } }
    __syncthreads();
    for (int p = tid; p < LP; p += NWAVES * 64) { const int c = p < NMETA ? 0 : ((p - NMETA) >> 6) + 1;
        F.SCB[(size_t)bh * LP + p] = sb[p]; F.SCM[(size_t)bh * LP + p] = sb[p] + fmaxf(sm0[c], sg[p]); F.WS[(size_t)bh * LP + p] = __expf(sB[c] - sb[p] + sig[p] - sm0[c + 1]); }
    if (tid < 34) F.M0[bh * 34 + tid] = sm0[tid];
    if (tid < 33) F.DEC[bh * 33 + tid] = __expf(sB[tid] + sm0[tid] - sm0[tid + 1]);
    __syncthreads();
}
constexpr int CK_STRIDE = 64, CV_STRIDE = 192, CK_BYTES = 64 * CK_STRIDE, CV_BYTES = 64 * CV_STRIDE, CBUF_BYTES = CK_BYTES + CV_BYTES;
__device__ __forceinline__ void s_chain(Frame& F, int unit) {
    const int bh = unit >> 3, ki = (unit >> 1) & 3, vh = unit & 1, b = bh >> 2, h = bh & 3, tid = F.tid, lane = F.lane, wave = F.wave;
    const bf16* Kp = F.P + 2 * P_STRIDE + h * HD + 32 * ki; const bf16* Vp = F.P + 3 * P_STRIDE + h * HD + 64 * vh;
    const float* WSp = F.WS + (size_t)bh * LP; const float* DECp = F.DEC + bh * 33;
    const int i16 = lane & 15, q4 = i16 >> 2, p4 = i16 & 3, blk = (lane >> 4) & 1, hh = lane >> 5, r32 = lane & 31;
    const bool cwave = wave < 2, nwave = (wave == 2) && (vh == 0);
    f32x16 acc;
#pragma unroll
    for (int i = 0; i < 16; ++i) acc[i] = 0.f;
    bf16x8 ones;
#pragma unroll
    for (int j = 0; j < 8; ++j) ones[j] = (r32 == 0) ? (short)0x3F80 : (short)0;
    const int vrow = tid >> 3, vcc = tid & 7, krow = (tid & 255) >> 2, kcc = tid & 3; const bool kthr = tid < 256;
    v4u vS[8], kS[8]; float wS[8];
#pragma unroll
    for (int j = 0; j < 8; ++j) { kS[j] = (v4u){0u, 0u, 0u, 0u}; wS[j] = 0.f; }
#define C_LOAD(c_, vS, kS, wS) do { const int T_ = chunk_T(c_), row0_ = chunk_row0(b, c_), p0_ = chunk_p0(c_); vS = (v4u){0u, 0u, 0u, 0u}; \
        if (vrow < T_) vS = *(const v4u*)(Vp + (size_t)(row0_ + vrow) * 512 + vcc * 8); \
        if (kthr) { kS = (v4u){0u, 0u, 0u, 0u}; wS = 0.f; if (krow < T_) { kS = *(const v4u*)(Kp + (size_t)(row0_ + krow) * 512 + kcc * 8); wS = WSp[p0_ + krow]; } } } while (0)
#define C_WRITE(vS, kS, wS, d_) do { *(LAS v4u*)(F.lds + (d_) * CBUF_BYTES + CK_BYTES + vrow * CV_STRIDE + vcc * 16) = vS; \
        if (kthr) { v4u w = kS; w.x = cvtpk(bflo(w.x) * wS, bfhi(w.x) * wS); w.y = cvtpk(bflo(w.y) * wS, bfhi(w.y) * wS); w.z = cvtpk(bflo(w.z) * wS, bfhi(w.z) * wS); w.w = cvtpk(bflo(w.w) * wS, bfhi(w.w) * wS); \
            *(LAS v4u*)(F.lds + (d_) * CBUF_BYTES + krow * CK_STRIDE + kcc * 16) = w; } } while (0)
#define C_COMPUTE(c_) do { const int cc_ = (c_); if (cwave || nwave) { const float dec = DECp[cc_]; \
        if (cc_ >= 1) { if (cwave) {   \
                bf16* Cs = F.CST + ((size_t)(bh * 32 + (cc_ - 1)) * 4 + 2 * vh + wave) * 4096 + (size_t)(2 * ki) * 512 + r32 * 8 + 4 * hh; \
                _Pragma("unroll") for (int g = 0; g < 4; ++g) { v2u w0; w0.x = cvtpk(acc[4 * g], acc[4 * g + 1]); w0.y = cvtpk(acc[4 * g + 2], acc[4 * g + 3]); *(v2u*)(Cs + (g >> 1) * 512 + (g & 1) * 256) = w0; } } \
            else if (r32 == 0) { float* Ns = F.NST + (size_t)(bh * 32 + (cc_ - 1)) * HD + 32 * ki + 4 * hh; \
                _Pragma("unroll") for (int g = 0; g < 4; ++g) { f32x4 o; o.x = acc[4 * g]; o.y = acc[4 * g + 1]; o.z = acc[4 * g + 2]; o.w = acc[4 * g + 3]; *(f32x4*)(Ns + 8 * g) = o; } } } \
        const LAS unsigned char* kb = F.lds + (cc_ & 1) * CBUF_BYTES; const LAS unsigned char* vb = kb + CK_BYTES; \
        bf16x8 Af[4], Bf[4]; \
        _Pragma("unroll") for (int s = 0; s < 4; ++s) { const int rlo = 16 * s + 8 * hh + q4; \
            Af[s] = cat8(vtr(kb + rlo * CK_STRIDE + 2 * (16 * blk + 4 * p4)), vtr(kb + (rlo + 4) * CK_STRIDE + 2 * (16 * blk + 4 * p4))); \
            if (cwave) Bf[s] = cat8(vtr(vb + rlo * CV_STRIDE + 2 * (32 * wave + 16 * blk + 4 * p4)), vtr(vb + (rlo + 4) * CV_STRIDE + 2 * (32 * wave + 16 * blk + 4 * p4))); else Bf[s] = ones; } \
        _Pragma("unroll") for (int i = 0; i < 16; ++i) acc[i] *= dec; \
        _Pragma("unroll") for (int s = 0; s < 4; ++s) acc = MFMA32(Af[s], Bf[s], acc); } } while (0)
    C_LOAD(0, vS[0], kS[0], wS[0]); C_WRITE(vS[0], kS[0], wS[0], 0);
#pragma unroll
    for (int j = 1; j < 8; ++j) C_LOAD(j, vS[j], kS[j], wS[j]);
    __syncthreads();
#define C_STEP(j) do { const int c_ = c + (j); if (c_ + 8 < 33) C_LOAD(c_ + 8, vS[j], kS[j], wS[j]); C_COMPUTE(c_); if (c_ + 1 < 33) C_WRITE(vS[((j) + 1) & 7], kS[((j) + 1) & 7], wS[((j) + 1) & 7], ((j) + 1) & 1); __syncthreads(); } while (0)
    for (int c = 0; c < 32; c += 8) { C_STEP(0); C_STEP(1); C_STEP(2); C_STEP(3); C_STEP(4); C_STEP(5); C_STEP(6); C_STEP(7); }
    { const int c = 32; C_COMPUTE(c); }
#undef C_STEP
#undef C_LOAD
#undef C_WRITE
#undef C_COMPUTE
    if (cwave) { float* Co = F.out + O_CP + (size_t)bh * HD * HD + 64 * vh + 32 * wave + r32;
#pragma unroll
        for (int i = 0; i < 16; ++i) Co[(size_t)(32 * ki + (i & 3) + 8 * (i >> 2) + 4 * hh) * HD] = acc[i]; }
    if (nwave && r32 == 0) {
#pragma unroll
        for (int i = 0; i < 16; ++i) F.out[O_NP + bh * HD + 32 * ki + (i & 3) + 8 * (i >> 2) + 4 * hh] = acc[i]; }
    if (unit == (bh << 3) && tid == 0) F.out[O_MP + bh] = F.M0[bh * 34 + 33];
    __syncthreads();
}

__device__ __forceinline__ void s_sample_pair(Frame& F, int pair) {
    const int lane = F.lane, wave = F.wave, w4 = wave & 3, task = 2 * pair + (wave >> 2);
    const int bs = task >> 2, h = task & 3, rowb = R_PROMPT + bs * DECT;
    LAS float* red = (LAS float*)F.lds + (wave >> 2) * (4 * 4 * HD);
    const float* Ci = F.state_C + (size_t)task * HD * HD; float* Co = F.out + O_CS + (size_t)task * HD * HD;
    f32x2 c2[32];
#pragma unroll
    for (int r = 0; r < 32; ++r) c2[r] = *(const f32x2*)(Ci + (size_t)(w4 * 32 + r) * HD + 2 * lane);
    float lf[4], ig[4], bt[4], mt[4];
    float q[4][2], k[4][2], vv[4][2], kw[4][2], n0[2];
    unsigned short qs_[4][2], ks_[4][2]; unsigned vw_[4];
#pragma unroll
    for (int t = 0; t < 4; ++t) {
        lf[t] = F.Gt[(size_t)(rowb + t) * 8 + 4 + h]; ig[t] = F.Gt[(size_t)(rowb + t) * 8 + h];
        const bf16* qr = F.P + 1 * P_STRIDE + (size_t)(rowb + t) * 512 + h * HD; const bf16* kr = F.P + 2 * P_STRIDE + (size_t)(rowb + t) * 512 + h * HD; const bf16* vr = F.P + 3 * P_STRIDE + (size_t)(rowb + t) * 512 + h * HD;
        qs_[t][0] = qr[lane]; qs_[t][1] = qr[lane + 64]; ks_[t][0] = kr[lane]; ks_[t][1] = kr[lane + 64]; vw_[t] = *(const unsigned*)(vr + 2 * lane);
    }
    const float m0 = F.state_m[task];
    n0[0] = F.state_n[task * HD + lane]; n0[1] = F.state_n[task * HD + lane + 64];
    const unsigned ow = *(const unsigned*)(F.P + 4 * P_STRIDE + (size_t)(rowb + w4) * 512 + h * HD + 2 * lane);
    { float mp = m0, ba = 0.f;
#pragma unroll
      for (int t = 0; t < 4; ++t) { ba += lf[t]; bt[t] = ba; mt[t] = fmaxf(lf[t] + mp, ig[t]); mp = mt[t]; } }
    const float ml = mt[3], dec = __expf(bt[3] + m0 - ml);
#pragma unroll
    for (int t = 0; t < 4; ++t) { q[t][0] = bf2f(qs_[t][0]); q[t][1] = bf2f(qs_[t][1]); k[t][0] = bf2f(ks_[t][0]); k[t][1] = bf2f(ks_[t][1]); vv[t][0] = bflo(vw_[t]); vv[t][1] = bfhi(vw_[t]);
        const float ws = __expf(bt[3] - bt[t] + ig[t] - ml); kw[t][0] = ws * k[t][0]; kw[t][1] = ws * k[t][1]; }
    float Pm[4][4], den[4], inter[4];
#pragma unroll
    for (int t = 0; t < 4; ++t) {
        inter[t] = __expf(bt[t] + m0 - mt[t]);
        float dsum = inter[t] * wave_sum(q[t][0] * n0[0] + q[t][1] * n0[1]);
#pragma unroll
        for (int s = 0; s < 4; ++s) { if (s <= t) { Pm[t][s] = wave_sum(q[t][0] * k[s][0] + q[t][1] * k[s][1]) * __expf(bt[t] - bt[s] + ig[s] - mt[t]); dsum += Pm[t][s]; } else Pm[t][s] = 0.f; }
        den[t] = fmaxf(fabsf(dsum), __expf(-mt[t]));
    }
    if (w4 == 0) { F.out[O_NS + task * HD + lane] = dec * n0[0] + (kw[0][0] + kw[1][0]) + (kw[2][0] + kw[3][0]); F.out[O_NS + task * HD + lane + 64] = dec * n0[1] + (kw[0][1] + kw[1][1]) + (kw[2][1] + kw[3][1]);
        if (lane == 0) F.out[O_MS + task] = ml; }
    float np[4][2];
#pragma unroll
    for (int t = 0; t < 4; ++t) { np[t][0] = 0.f; np[t][1] = 0.f; }
    LAS float* tab = (LAS float*)F.lds + 8192 + wave * 1024;
    { f32x4 x; x.x = q[0][0]; x.y = q[1][0]; x.z = q[2][0]; x.w = q[3][0]; *(LAS f32x4*)(tab + 8 * lane) = x; x.x = kw[0][0]; x.y = kw[1][0]; x.z = kw[2][0]; x.w = kw[3][0]; *(LAS f32x4*)(tab + 8 * lane + 4) = x;
      x.x = q[0][1]; x.y = q[1][1]; x.z = q[2][1]; x.w = q[3][1]; *(LAS f32x4*)(tab + 8 * (lane + 64)) = x; x.x = kw[0][1]; x.y = kw[1][1]; x.z = kw[2][1]; x.w = kw[3][1]; *(LAS f32x4*)(tab + 8 * (lane + 64) + 4) = x; }
    LDS_WAIT(); asm volatile("" ::: "memory");
#pragma unroll
    for (int r = 0; r < 32; ++r) {
        const f32x4 qs = *(const LAS f32x4*)(tab + 8 * (w4 * 32 + r)), ks = *(const LAS f32x4*)(tab + 8 * (w4 * 32 + r) + 4);
        float o0 = dec * c2[r].x, o1 = dec * c2[r].y;
#pragma unroll
        for (int t = 0; t < 4; ++t) { o0 += ks[t] * vv[t][0]; o1 += ks[t] * vv[t][1]; np[t][0] += qs[t] * c2[r].x; np[t][1] += qs[t] * c2[r].y; }
        f32x2 o; o.x = o0; o.y = o1; *(f32x2*)(Co + (size_t)(w4 * 32 + r) * HD + 2 * lane) = o;
    }
#pragma unroll
    for (int t = 0; t < 4; ++t) { f32x2 o; o.x = np[t][0]; o.y = np[t][1]; *(LAS f32x2*)(red + (w4 * 4 + t) * HD + 2 * lane) = o; }
    __syncthreads();
#pragma unroll
    for (int t = 0; t < 4; ++t) if (w4 == t) {
        float a0 = 0.f, a1 = 0.f;
#pragma unroll
        for (int w = 0; w < 4; ++w) { const f32x2 x = *(const LAS f32x2*)(red + (w * 4 + t) * HD + 2 * lane); a0 += x.x; a1 += x.y; }
        a0 *= inter[t]; a1 *= inter[t];
#pragma unroll
        for (int s = 0; s < 4; ++s) if (s <= t) { a0 += Pm[t][s] * vv[s][0]; a1 += Pm[t][s] * vv[s][1]; }
        const float h0 = a0 / den[t], h1 = a1 / den[t];
        const float rn = 1.f / sqrtf(wave_sum(h0 * h0 + h1 * h1) * (1.f / HD) + EPS);
        *(unsigned*)(F.MIX + (size_t)(rowb + t) * D + PW + h * HD + 2 * lane) = pk2(h0 * rn * sigmoidf_(bflo(ow)), h1 * rn * sigmoidf_(bfhi(ow)));
    }
    __syncthreads();
}
__device__ __forceinline__ void p2_state(Frame& F) {
    for (int u = (int)blockIdx.x; u < NB * NH * 8; u += F.G) s_chain(F, u);
    for (int pair = (int)blockIdx.x; pair < DECB * NH / 2; pair += F.G) s_sample_pair(F, pair);
}

#define SCHED_FENCE() __builtin_amdgcn_sched_barrier(0)
__device__ __forceinline__ void mlstm_out_unit(Frame& F, int u) {
    const int lane = F.lane, wave = F.wave, tid = F.tid;
    const int i16 = lane & 15, q4 = i16 >> 2, p4 = i16 & 3, blk = (lane >> 4) & 1, hh = lane >> 5, r32 = lane & 31;
    const int b = u >> 5, c = (u & 31) + 1, row0 = b * SEQ + (c - 1) * 64, p0 = NMETA + (c - 1) * 64;
    LAS float* sa = (LAS float*)(F.lds + 4 * IMG_BYTES);
    LAS float* sn = sa + 256;
    const int h = wave >> 1, th = wave & 1, bh = b * 4 + h;
    const int t = 32 * th + r32, row = row0 + t;
    v4u vw[8];
#pragma unroll
    for (int i = 0; i < 8; ++i) { const int id = tid + 512 * i, vr = id >> 6, cc = id & 63; vw[i] = *(const v4u*)(F.P + 3 * P_STRIDE + (size_t)(row0 + vr) * 512 + cc * 8); }
    float av = 0.f;
    if (tid < 256) { const int hd = tid >> 6, s = tid & 63; av = F.Gt[(size_t)(row0 + s) * 8 + hd] - F.SCB[(size_t)((b * 4 + hd)) * LP + p0 + s]; }
    const float bt = F.SCB[(size_t)bh * LP + p0 + t], mt = F.SCM[(size_t)bh * LP + p0 + t], m0c = F.M0[bh * 34 + c];
    bf16x8 qf[8];
#pragma unroll
    for (int s = 0; s < 8; ++s) qf[s] = *(const bf16x8*)(F.P + 1 * P_STRIDE + (size_t)row * 512 + h * HD + 16 * s + 8 * hh);
    const float nv = F.NST[(size_t)((b * 4 + (tid >> 7)) * 32 + (c - 1)) * HD + (tid & 127)];
    const bf16* Cs = F.CST + ((size_t)(bh * 32 + (c - 1)) * 4) * 4096 + lane * 8;
    bf16x8 A0[8], A1[8];
#pragma unroll
    for (int s = 0; s < 8; ++s) A0[s] = *(const bf16x8*)(Cs + 0 * 4096 + 512 * s);
    SCHED_FENCE();
#pragma unroll
    for (int i = 0; i < 8; ++i) { const int id = tid + 512 * i, vr = id >> 6, cc = id & 63; *(LAS v4u*)(F.lds + (cc >> 4) * IMG_BYTES + vr * IMG_STRIDE + (cc & 15) * 16) = vw[i]; }
    if (tid < 256) sa[tid] = av;
    sn[tid] = nv;
    SCHED_FENCE();
#pragma unroll
    for (int s = 0; s < 8; ++s) A1[s] = *(const bf16x8*)(Cs + 1 * 4096 + 512 * s);
    SCHED_FENCE();
    __syncthreads();
    SCHED_FENCE();
    const float ct = bt - mt, inter = __expf(bt + m0c - mt), emt = __expf(-mt);
    float qn = 0.f;
#pragma unroll
    for (int s = 0; s < 8; ++s) { const f32x4 n0a = *(const LAS f32x4*)(sn + h * HD + 16 * s + 8 * hh), n0b = *(const LAS f32x4*)(sn + h * HD + 16 * s + 8 * hh + 4); const v4u qw = __builtin_bit_cast(v4u, qf[s]);
        qn += (bflo(qw.x) * n0a.x + bfhi(qw.x) * n0a.y) + (bflo(qw.y) * n0a.z + bfhi(qw.y) * n0a.w) + (bflo(qw.z) * n0b.x + bfhi(qw.z) * n0b.y) + (bflo(qw.w) * n0b.z + bfhi(qw.w) * n0b.w); }
    qn += __shfl_xor(qn, 32);
    SCHED_FENCE();
    f32x16 OT[4];
#pragma unroll
    for (int vt = 0; vt < 4; ++vt)
#pragma unroll
        for (int i = 0; i < 16; ++i) OT[vt][i] = 0.f;
#pragma unroll
    for (int s = 0; s < 8; ++s) OT[0] = MFMA32(A0[s], qf[s], OT[0]);
    SCHED_FENCE();
#pragma unroll
    for (int s = 0; s < 8; ++s) A0[s] = *(const bf16x8*)(Cs + 2 * 4096 + 512 * s);
    SCHED_FENCE();
#pragma unroll
    for (int s = 0; s < 8; ++s) OT[1] = MFMA32(A1[s], qf[s], OT[1]);
    SCHED_FENCE();
#pragma unroll
    for (int s = 0; s < 8; ++s) A1[s] = *(const bf16x8*)(Cs + 3 * 4096 + 512 * s);
    SCHED_FENCE();
#pragma unroll
    for (int s = 0; s < 8; ++s) OT[2] = MFMA32(A0[s], qf[s], OT[2]);
    SCHED_FENCE();
    const bf16* Kr = F.P + 2 * P_STRIDE + (size_t)(row0 + r32) * 512 + h * HD + 8 * hh;
#pragma unroll
    for (int s = 0; s < 8; ++s) A0[s] = *(const bf16x8*)(Kr + 16 * s);
    SCHED_FENCE();
#pragma unroll
    for (int s = 0; s < 8; ++s) OT[3] = MFMA32(A1[s], qf[s], OT[3]);
    SCHED_FENCE();
    SCHED_FENCE();
#pragma unroll
    for (int vt = 0; vt < 4; ++vt)
#pragma unroll
        for (int i = 0; i < 16; ++i) OT[vt][i] *= inter;
    float csum = 0.f;
    const LAS unsigned char* vimg = F.lds + h * IMG_BYTES;
#pragma unroll
    for (int stile = 0; stile < 2; ++stile) if (stile <= th) {
        f32x16 ST;
#pragma unroll
        for (int i = 0; i < 16; ++i) ST[i] = 0.f;
#pragma unroll
        for (int s = 0; s < 8; ++s) ST = MFMA32(A0[s], qf[s], ST);
        if (stile == 0 && th) {
            SCHED_FENCE();
#pragma unroll
            for (int s = 0; s < 8; ++s) A0[s] = *(const bf16x8*)(Kr + (size_t)32 * 512 + 16 * s);
            SCHED_FENCE();
        }
        const float tl = (stile == th) ? (float)(r32 - 4 * hh) : 1e9f;
#pragma unroll
        for (int g = 0; g < 4; ++g) { const f32x4 as4 = *(const LAS f32x4*)(sa + h * 64 + 32 * stile + 8 * g + 4 * hh);
#pragma unroll
            for (int e = 0; e < 4; ++e) { const float dv = __expf(fminf(tl - (float)(8 * g + e), 0.f) * 1e30f + (ct + as4[e])); const float pv = ST[4 * g + e] * dv; ST[4 * g + e] = pv; csum += pv; } }
#pragma unroll
        for (int ks = 0; ks < 2; ++ks) {
            v4u pw; pw.x = cvtpk(ST[8 * ks], ST[8 * ks + 1]); pw.y = cvtpk(ST[8 * ks + 2], ST[8 * ks + 3]); pw.z = cvtpk(ST[8 * ks + 4], ST[8 * ks + 5]); pw.w = cvtpk(ST[8 * ks + 6], ST[8 * ks + 7]);
            const bf16x8 Pf = __builtin_bit_cast(bf16x8, pw);
            const int rlo = 32 * stile + 16 * ks + 4 * hh + q4;
            bf16x8 Vf[4];
#pragma unroll
            for (int vt = 0; vt < 4; ++vt) Vf[vt] = cat8(vtr(vimg + rlo * IMG_STRIDE + 2 * (32 * vt + 16 * blk + 4 * p4)), vtr(vimg + (rlo + 8) * IMG_STRIDE + 2 * (32 * vt + 16 * blk + 4 * p4)));
#pragma unroll
            for (int vt = 0; vt < 4; ++vt) OT[vt] = MFMA32(Vf[vt], Pf, OT[vt]);
        }
    }
    v2u ow[16];
#pragma unroll
    for (int vt = 0; vt < 4; ++vt)
#pragma unroll
        for (int g = 0; g < 4; ++g) ow[4 * vt + g] = *(const v2u*)(F.P + 4 * P_STRIDE + (size_t)row * 512 + h * HD + 32 * vt + 8 * g + 4 * hh);
    SCHED_FENCE();
    csum += __shfl_xor(csum, 32);
    const float den = fmaxf(fabsf(inter * qn + csum), emt), rden = 1.f / den;
    float ss = 0.f;
#pragma unroll
    for (int vt = 0; vt < 4; ++vt)
#pragma unroll
        for (int i = 0; i < 16; ++i) { OT[vt][i] *= rden; ss += OT[vt][i] * OT[vt][i]; }
    ss += __shfl_xor(ss, 32);
    const float rn = 1.f / sqrtf(ss * (1.f / HD) + EPS);
#pragma unroll
    for (int vt = 0; vt < 4; ++vt)
#pragma unroll
        for (int g = 0; g < 4; ++g) { const int v0 = 32 * vt + 8 * g + 4 * hh; const v2u o2 = ow[4 * vt + g];
            v2u w; w.x = cvtpk(OT[vt][4 * g] * rn * sigmoidf_(bflo(o2.x)), OT[vt][4 * g + 1] * rn * sigmoidf_(bfhi(o2.x)));
            w.y = cvtpk(OT[vt][4 * g + 2] * rn * sigmoidf_(bflo(o2.y)), OT[vt][4 * g + 3] * rn * sigmoidf_(bfhi(o2.y)));
            *(v2u*)(F.MIX + (size_t)row * D + PW + h * HD + v0) = w; }
    __syncthreads();
}

template <int NT> __device__ __forceinline__ void pool_tokens(const v4u (&rw)[15 + NT], int g, bf16* dst  ) {
    const float invw = g == 0 ? 0.5f : g == 1 ? 0.25f : g == 2 ? 0.125f : 0.0625f, m4 = g >= 1 ? 1.f : 0.f, m8 = g >= 2 ? 1.f : 0.f, m16 = g >= 3 ? 1.f : 0.f;
    unsigned ow[NT][4];
#pragma unroll
    for (int k = 0; k < 4; ++k) {
        float lo[15 + NT], hi[15 + NT];
#pragma unroll
        for (int i = 0; i < 15 + NT; ++i) { const unsigned w = rw[i][k]; lo[i] = bflo(w); hi[i] = bfhi(w); }
#pragma unroll
        for (int t = 0; t < NT; ++t) { const int i = 15 + t;
            const float a2 = lo[i] + lo[i - 1], a4 = lo[i - 2] + lo[i - 3], a8 = (lo[i - 4] + lo[i - 5]) + (lo[i - 6] + lo[i - 7]);
            const float a16 = ((lo[i - 8] + lo[i - 9]) + (lo[i - 10] + lo[i - 11])) + ((lo[i - 12] + lo[i - 13]) + (lo[i - 14] + lo[i - 15]));
            const float b2 = hi[i] + hi[i - 1], b4 = hi[i - 2] + hi[i - 3], b8 = (hi[i - 4] + hi[i - 5]) + (hi[i - 6] + hi[i - 7]);
            const float b16 = ((hi[i - 8] + hi[i - 9]) + (hi[i - 10] + hi[i - 11])) + ((hi[i - 12] + hi[i - 13]) + (hi[i - 14] + hi[i - 15]));
            const float pa = (a2 + m4 * a4 + m8 * a8 + m16 * a16) * invw - lo[i];
            const float pb = (b2 + m4 * b4 + m8 * b8 + m16 * b16) * invw - hi[i];
            ow[t][k] = cvtpk(pa, pb); }
    }
#pragma unroll
    for (int t = 0; t < NT; ++t) { v4u w; w.x = ow[t][0]; w.y = ow[t][1]; w.z = ow[t][2]; w.w = ow[t][3]; *(v4u*)(dst + (size_t)t * D) = w; }
}
__device__ __forceinline__ void pool_unit(Frame& F, int u) {
    const int lane = F.lane, wave = F.wave;
    const bf16* U = F.P;
    const int g_l = lane >> 4;
    if (u < NB * 32) {
        const int b = u >> 5, tr0 = (u & 31) * 64;
        v4u rw[23];
#pragma unroll
        for (int i = 0; i < 23; ++i) { const int tr = tr0 + 8 * wave - 15 + i; const int r = tr >= 0 ? b * SEQ + tr : R_META0 + NMETA + tr; rw[i] = *(const v4u*)(U + (size_t)r * 512 + 8 * lane); }
        pool_tokens<8>(rw, g_l, F.MIX + (size_t)(b * SEQ + tr0 + 8 * wave) * D + 8 * lane);
    } else {
        const int su = u - NB * 32;
#pragma unroll
        for (int sq = 0; sq < 2; ++sq) { const int seq = su * 16 + 2 * wave + sq;
            v4u rw[19];
#pragma unroll
            for (int i = 0; i < 15; ++i) { const float* cr = F.state_pool + ((size_t)seq * 15 + i) * 512 + 8 * lane; const f32x4 x0 = *(const f32x4*)cr, x1 = *(const f32x4*)(cr + 4);
                rw[i].x = cvtpk(x0.x, x0.y); rw[i].y = cvtpk(x0.z, x0.w); rw[i].z = cvtpk(x1.x, x1.y); rw[i].w = cvtpk(x1.z, x1.w); }
#pragma unroll
            for (int i = 0; i < 4; ++i) rw[15 + i] = *(const v4u*)(U + (size_t)(R_PROMPT + seq * DECT + i) * 512 + 8 * lane);
            pool_tokens<4>(rw, g_l, F.MIX + (size_t)(R_PROMPT + seq * DECT) * D + 8 * lane); }
    }
}
__device__ __forceinline__ void p3_out(Frame& F) {
    for (int u = (int)blockIdx.x; u < NB * 32; u += F.G) mlstm_out_unit(F, u);
    for (int u = (int)blockIdx.x; u < NB * 32 + R_SAMPLE / 64; u += F.G) pool_unit(F, u);
}

__device__ __forceinline__ void fold_pool_tile(Frame& F, int id) {
    const int g = id >> 7, n0 = 32 * ((id >> 2) & 31), c0 = 32 * (id & 3), lane = F.lane, r32 = lane & 31, hh = lane >> 5;
    f32x16 acc;
#pragma unroll
    for (int i = 0; i < 16; ++i) acc[i] = 0.f;
    bf16x8 A[8]; f32x4 wa[8], wb[8], sa_[8], sb_[8];
#pragma unroll
    for (int s = 0; s < 8; ++s) { A[s] = *(const bf16x8*)(F.WoRaw + (size_t)(n0 + r32) * PW + g * 128 + 16 * s + 8 * hh);
        const float* wp = F.w_pool + (size_t)g * 16384 + (size_t)(c0 + r32) * 128 + 16 * s + 8 * hh; const float* sc = F.pool_scale + g * 128 + 16 * s + 8 * hh;
        wa[s] = *(const f32x4*)wp; wb[s] = *(const f32x4*)(wp + 4); sa_[s] = *(const f32x4*)sc; sb_[s] = *(const f32x4*)(sc + 4); }
#pragma unroll
    for (int s = 0; s < 8; ++s) { const f32x4 x = wa[s] * sa_[s], y = wb[s] * sb_[s]; v4u w; w.x = cvtpk(x.x, x.y); w.y = cvtpk(x.z, x.w); w.z = cvtpk(y.x, y.y); w.w = cvtpk(y.z, y.w);
        acc = MFMA32(A[s], __builtin_bit_cast(bf16x8, w), acc); }
#pragma unroll
    for (int i = 0; i < 16; ++i) { const int n = n0 + (i & 3) + 8 * (i >> 2) + 4 * hh; F.Wout_t[(size_t)n * D + g * 128 + c0 + r32] = (bf16)f2bf(acc[i]); }
}

__device__ __forceinline__ void p3_poolstate(Frame& F) {
    const int gt = blockIdx.x * (NWAVES * 64) + F.tid, ngt = F.G * NWAVES * 64;
    for (int e = gt; e < NB * 15 * 512; e += ngt) { const int c = e & 511, i = (e >> 9) % 15, b = e / (15 * 512); F.out[O_POOLP + e] = bf2f(F.P[(size_t)(b * SEQ + SEQ - 15 + i) * 512 + c]); }
    for (int e = gt; e < DECB * 15 * 512; e += ngt) { const int c = e & 511, i = (e >> 9) % 15, b = e / (15 * 512);
        F.out[O_POOLS + e] = (i < 11) ? F.state_pool[((size_t)b * 15 + i + 4) * 512 + c] : bf2f(F.P[(size_t)(R_PROMPT + b * DECT + (i - 11)) * 512 + c]); }
}

template <int EPI> __device__ __forceinline__ void small_gemm_tile(Frame& F, const bf16* A, int lda, const bf16* Wt, int ldw, int k0, int nk, int m0, int n0, const float* res, void* outp, int ldo) {
    const int tid = F.tid, lane = F.lane, wave = F.wave, wm = wave >> 2, wn = wave & 3, r32 = lane & 31, hh = lane >> 5;
    constexpr int BUF = 24576, AOFF = 0, WOFF = 8192;
    const int arow = tid >> 3, ach = tid & 7;
    const bf16* ag = A + (size_t)(m0 + arow) * lda + k0 + ach * 8; const bf16* wg0 = Wt + (size_t)(n0 + arow) * ldw + k0 + ach * 8; const bf16* wg1 = wg0 + (size_t)64 * ldw;
    const int sw = (ach ^ (arow & 7)) * 16;
    v4u ra[4], rw0[4], rw1[4];
    f32x16 acc;
#pragma unroll
    for (int i = 0; i < 16; ++i) acc[i] = 0.f;
#define SG_LOAD(j, kt_) do { ra[j] = *(const v4u*)(ag + (kt_) * 64); rw0[j] = *(const v4u*)(wg0 + (kt_) * 64); rw1[j] = *(const v4u*)(wg1 + (kt_) * 64); } while (0)
#define SG_WRITE(j, d_) do { LAS unsigned char* nb = F.lds + (d_) * BUF; *(LAS v4u*)(nb + AOFF + arow * 128 + sw) = ra[j]; *(LAS v4u*)(nb + WOFF + arow * 128 + sw) = rw0[j]; *(LAS v4u*)(nb + WOFF + (arow + 64) * 128 + sw) = rw1[j]; } while (0)
#define SG_STEP(j) do { const int kt_ = kt + (j); const LAS unsigned char* buf = F.lds + ((j) & 1) * BUF; \
        bf16x8 wf[4], xf[4]; \
        _Pragma("unroll") for (int s = 0; s < 4; ++s) { wf[s] = *(const LAS bf16x8*)(buf + WOFF + wrow * 128 + (((2 * s + hh) ^ (wrow & 7)) * 16)); xf[s] = *(const LAS bf16x8*)(buf + AOFF + xrow * 128 + (((2 * s + hh) ^ (xrow & 7)) * 16)); } \
        if (kt_ + 4 < nk) SG_LOAD(j, kt_ + 4); \
        _Pragma("unroll") for (int s = 0; s < 4; ++s) acc = MFMA32(wf[s], xf[s], acc); \
        if (kt_ + 1 < nk) SG_WRITE(((j) + 1) & 3, ((j) + 1) & 1); \
        __syncthreads(); } while (0)
    const int wrow = 32 * wn + r32, xrow = 32 * wm + r32;
    SG_LOAD(0, 0); SG_LOAD(1, 1); SG_LOAD(2, 2); SG_LOAD(3, 3);
    SG_WRITE(0, 0);
    __syncthreads();
    for (int kt = 0; kt < nk; kt += 4) { SG_STEP(0); SG_STEP(1); SG_STEP(2); SG_STEP(3); }
#undef SG_LOAD
#undef SG_WRITE
#undef SG_STEP
    const int t = m0 + xrow;
#pragma unroll
    for (int g = 0; g < 4; ++g) { const int n = n0 + 32 * wn + 8 * g + 4 * hh;
        if (EPI == 0) { float* o = (float*)outp + (size_t)t * ldo + n; const f32x4 r = *(const f32x4*)(res + (size_t)t * ldo + n); f32x4 v; v.x = r.x + acc[4 * g]; v.y = r.y + acc[4 * g + 1]; v.z = r.z + acc[4 * g + 2]; v.w = r.w + acc[4 * g + 3]; *(f32x4*)o = v; }
        else if (EPI == 1) { bf16* o = (bf16*)outp + (size_t)t * ldo + n; float a0 = fmaxf(acc[4 * g], 0.f), a1 = fmaxf(acc[4 * g + 1], 0.f), a2 = fmaxf(acc[4 * g + 2], 0.f), a3 = fmaxf(acc[4 * g + 3], 0.f); v2u w; w.x = cvtpk(a0 * a0, a1 * a1); w.y = cvtpk(a2 * a2, a3 * a3); *(v2u*)o = w; }
        else { float* o = (float*)outp + (size_t)t * ldo + n; f32x4 v; v.x = acc[4 * g]; v.y = acc[4 * g + 1]; v.z = acc[4 * g + 2]; v.w = acc[4 * g + 3]; *(f32x4*)o = v; }
    }
}

__device__ __forceinline__ void p5_norm2(Frame& F) {
    for (int m = F.gw; m < R_MAIN; m += F.NGW) { f32x4 xn[4]; rms_row_to_bf16(F.out + O_Y + (size_t)m * D, F.norm2, F.XN + (size_t)m * D, F.lane, xn); }
}
__device__ __forceinline__ void p8_final(Frame& F) {
    for (int m = F.gw; m < R_MAIN; m += F.NGW) {
        GAS f32x4* xr = (GAS f32x4*)(F.out + O_Y + (size_t)m * D) + F.lane; const GAS f32x4* gr = (const GAS f32x4*)F.norm_f + F.lane;
        f32x4 v[4]; float s = 0.f;
#pragma unroll
        for (int j = 0; j < 4; ++j) { v[j] = xr[64 * j];
            if (m >= R_PROMPT) {
#pragma unroll
                for (int ks = 0; ks < 4; ++ks) v[j] += ((const GAS f32x4*)(F.SLAB + ((size_t)ks * R_SAMPLE + (m - R_PROMPT)) * D) + F.lane)[64 * j]; }
            s += (v[j].x * v[j].x + v[j].y * v[j].y) + (v[j].z * v[j].z + v[j].w * v[j].w); }
        const float r = 1.f / sqrtf(wave_sum(s) * (1.f / D) + EPS);
#pragma unroll
        for (int j = 0; j < 4; ++j) xr[64 * j] = v[j] * r * gr[64 * j];
    }
}

struct Args { const float* in[18]; float* out; unsigned char* ws; int ph_lo, ph_hi; };
__global__ void __launch_bounds__(NWAVES * 64, 2) fwd_kernel(Args args) {
    extern __shared__ __attribute__((aligned(16))) unsigned char lds[];
    Frame F;
    F.lds = (LAS unsigned char*)lds;
    F.tid = threadIdx.x; F.lane = F.tid & 63; F.wave = __builtin_amdgcn_readfirstlane(F.tid >> 6);
    F.G = gridDim.x; F.gw = blockIdx.x * NWAVES + F.wave; F.NGW = F.G * NWAVES;
    F.x_prompt = args.in[0]; F.x_sample = args.in[1]; F.state_pool = args.in[2]; F.state_C = args.in[3]; F.state_n = args.in[4]; F.state_m = args.in[5]; F.meta = args.in[6]; F.norm1 = args.in[7];
    F.w_in = args.in[8]; F.b_gate = args.in[9]; F.w_pool = args.in[10]; F.pool_scale = args.in[11]; F.head_gain = args.in[12]; F.w_out = args.in[13]; F.norm2 = args.in[14]; F.w_up = args.in[15];
    F.w_down = args.in[16]; F.norm_f = args.in[17]; F.out = args.out;
    unsigned char* ws = args.ws;
    F.Win_t = (bf16*)(ws + WS_WIN); F.Wout_t = (bf16*)(ws + WS_WOUT); F.Wup_t = (bf16*)(ws + WS_WUP); F.Wdn_t = (bf16*)(ws + WS_WDN);
    F.Gt = (float*)(ws + WS_G); F.XN = (bf16*)(ws + WS_XN); F.P = (bf16*)(ws + WS_P); F.MIX = (bf16*)(ws + WS_MIX); F.CST = (bf16*)(ws + WS_CST); F.WoRaw = (bf16*)(ws + WS_WORAW); F.NST = (float*)(ws + WS_NST); F.SCB = (float*)(ws + WS_SCB); F.SCM = (float*)(ws + WS_SCM); F.M0 = (float*)(ws + WS_M0); F.WS = (float*)(ws + WS_WSA); F.DEC = (float*)(ws + WS_DEC); F.SLAB = (float*)(ws + WS_SLAB); F.H = (bf16*)(ws + WS_H);
    for (int u = F.tid; u < (LDS_BYTES - RING_BYTES) / 4; u += NWAVES * 64) ((LAS unsigned*)(F.lds + RING_BYTES))[u] = 0u;
    __syncthreads();
    XcdBarrier bar = xcd_barrier_post((unsigned*)(ws + WS_CTL) + CW_BAR, (volatile LAS unsigned*)(F.lds + MISC_OFF) + 8);
    const int lo = args.ph_lo, hi = args.ph_hi;
#define IN(k) (lo <= (k) && (k) < hi)
#define GRID_BAR() xcd_barrier(bar)
    if (IN(0)) { p0_prologue(F); }
    if (IN(0) && IN(1)) GRID_BAR();
    if (IN(1)) { pg8::Gemm g{F.XN, F.Win_t, M_IN, NIN, D}; pg8::StaticOrder S; S.init(M_IN, NIN, F.G, (int)blockIdx.x);
        pg8::EpiIn E{F.P, P_STRIDE, 0.08838834764831845f};
        pg8::gemm_phase<pg8::EpiIn, pg8::StaticOrder, PG8_ALIGN, PG8_SP2>(F.lds, g, S, E);
        { const int first_idle = ((M_IN / 256) * (NIN / 256)) % F.G, nidle = first_idle ? F.G - first_idle : F.G, rank = first_idle ? (int)blockIdx.x - first_idle : (int)blockIdx.x;
          if (rank >= 0) { for (int bh = rank; bh < NB * NH; bh += nidle) s_scan(F, bh);
              for (int id = rank * NWAVES + F.wave; id < 512; id += nidle * NWAVES) fold_pool_tile(F, id); } } }
    if (IN(1) && IN(2)) GRID_BAR();
    if (IN(2)) { p2_state(F); }
    if (IN(2) && IN(3)) GRID_BAR();
    if (IN(3)) { p3_out(F); p3_poolstate(F); }
    if (IN(3) && IN(4)) GRID_BAR();
    if (IN(4)) { pg8::Gemm g{F.MIX, F.Wout_t, R_PROMPT, D, D}; pg8::StaticOrder S; S.init(R_PROMPT, D, F.G, (int)blockIdx.x);
        pg8::EpiRes E{F.x_prompt, F.x_sample, R_PROMPT / 256, F.out + O_Y};
        pg8::gemm_phase<pg8::EpiRes, pg8::StaticOrder, PG8_ALIGN, PG8_SP2>(F.lds, g, S, E);
        for (int tl = (int)blockIdx.x; tl < (R_SAMPLE / 64) * (D / 128); tl += F.G)
            small_gemm_tile<0>(F, F.MIX + (size_t)R_PROMPT * D, D, F.Wout_t, D, 0, D / 64, (tl >> 3) * 64, (tl & 7) * 128, F.x_sample, F.out + O_Y + (size_t)R_PROMPT * D, D); }
    if (IN(4) && IN(5)) GRID_BAR();
    if (IN(5)) { p5_norm2(F); }
    if (IN(5) && IN(6)) GRID_BAR();
    if (IN(6)) { pg8::Gemm g{F.XN, F.Wup_t, R_PROMPT, FF, D}; pg8::StaticOrder S; S.init(R_PROMPT, FF, F.G, (int)blockIdx.x);
        pg8::EpiRelu2 E{F.H, FF};
        pg8::gemm_phase<pg8::EpiRelu2, pg8::StaticOrder, PG8_ALIGN, PG8_SP2>(F.lds, g, S, E);
        for (int tl = (int)blockIdx.x; tl < (R_SAMPLE / 64) * (FF / 128); tl += F.G)
            small_gemm_tile<1>(F, F.XN + (size_t)R_PROMPT * D, D, F.Wup_t, D, 0, D / 64, (tl >> 5) * 64, (tl & 31) * 128, nullptr, F.H + (size_t)R_PROMPT * FF, FF); }
    if (IN(6) && IN(7)) GRID_BAR();
    if (IN(7)) { pg8::Gemm g{F.H, F.Wdn_t, R_PROMPT, D, FF}; pg8::StaticOrder S; S.init(R_PROMPT, D, F.G, (int)blockIdx.x);
        pg8::EpiRes E{F.out + O_Y, F.out + O_Y, 1 << 20, F.out + O_Y};
        pg8::gemm_phase<pg8::EpiRes, pg8::StaticOrder, PG8_ALIGN, PG8_SP2>(F.lds, g, S, E);
        for (int tl = (int)blockIdx.x; tl < (R_SAMPLE / 64) * (D / 128) * 4; tl += F.G) { const int ks = tl & 3, t2 = tl >> 2;
            small_gemm_tile<2>(F, F.H + (size_t)R_PROMPT * FF, FF, F.Wdn_t, FF, ks * (FF / 4), FF / 4 / 64, (t2 >> 3) * 64, (t2 & 7) * 128, nullptr, F.SLAB + (size_t)ks * R_SAMPLE * D, D); } }
    if (IN(7) && IN(8)) GRID_BAR();
    if (IN(8)) { p8_final(F); }
#undef IN
#undef GRID_BAR
}

extern "C" void kernel_launch(void* const* d_in, const int* in_sizes, int n_in, void* d_out, int out_size, void* d_ws, size_t ws_size, hipStream_t stream) {
    static int grid = 0;
    if (grid == 0) {
        if (n_in != 18 || out_size != (int)O_END || ws_size < WS_END) { fprintf(stderr, "kernel_launch: unexpected shapes n_in %d out %d ws %zu\n", n_in, out_size, ws_size); grid = -1; return; }
        int dev = 0, cus = 0;
        if (hipGetDevice(&dev) != hipSuccess || hipDeviceGetAttribute(&cus, hipDeviceAttributeMultiprocessorCount, dev) != hipSuccess) { grid = -1; return; }
        if (hipFuncSetAttribute((const void*)fwd_kernel, hipFuncAttributeMaxDynamicSharedMemorySize, LDS_BYTES) != hipSuccess) { fprintf(stderr, "kernel_launch: hipFuncSetAttribute failed\n"); grid = -1; return; }
        grid = cus;
    }
    if (grid < 0) return;
    Args a{};
    for (int i = 0; i < 18; ++i) a.in[i] = (const float*)d_in[i];
    a.out = (float*)d_out; a.ws = (unsigned char*)d_ws;
    if (hipMemsetAsync((char*)d_ws + WS_CTL, 0, CTL_ZERO_BYTES, stream) != hipSuccess) { fprintf(stderr, "kernel_launch: memset failed\n"); return; }
    a.ph_lo = 0; a.ph_hi = 9; hipLaunchKernelGGL(fwd_kernel, dim3(grid), dim3(NWAVES * 64), LDS_BYTES, stream, a);
}
```
